# Optimizing an MI355X kernel written in HIP

```python
import jax, jax.numpy as jnp
from jax import lax
import numpy as np

D_MODEL = 1024
BATCH = 8
SEQ = 4096
DEPTH = 1

DA_HEADS = 4
DA_QK_DIM = 64
DA_V_DIM = 2 * DA_QK_DIM
DA_ROT_DIM = DA_QK_DIM // 4
ROPE_THETA = 500000.0
RET_HEADS = 4
RET_QK_DIM = 128
RET_V_DIM = 256
RET_THETA_BASE = 10000.0
D_FF = 4 * D_MODEL
N_BRANCH = 2
Q_BLOCK = 128
RET_CHUNK = 128
NORM_EPS = 1e-6
SUBLN_EPS = 1e-5
GN_EPS = 1e-5
MASK_VALUE = -1e30

DA_QK_W = DA_HEADS * 2 * DA_QK_DIM
DA_V_W = DA_HEADS * DA_V_DIM
RET_QK_W = RET_HEADS * RET_QK_DIM
RET_V_W = RET_HEADS * RET_V_DIM
GATE_W = N_BRANCH * D_MODEL
SPLIT_SIZES = (DA_QK_W, DA_QK_W, DA_V_W, RET_QK_W, RET_QK_W, RET_V_W, RET_V_W, GATE_W)
IN_W = sum(SPLIT_SIZES)
SPLIT_POINTS = tuple(int(v) for v in np.cumsum(SPLIT_SIZES)[:-1])

kernel_name = "hybrid_diffattn_retention_block"


def rms_norm(t, w, eps):
    tf = t.astype(jnp.float32)
    tf = tf * lax.rsqrt(jnp.mean(tf * tf, axis=-1, keepdims=True) + eps)
    return tf * w.astype(jnp.float32)


def rotate_half(t, cos, sin):
    t1, t2 = jnp.split(t, 2, axis=-1)
    return jnp.concatenate([t1 * cos - t2 * sin, t1 * sin + t2 * cos], axis=-1)


def diff_attention(q, k, v, lam):
    B, S, H, _, d = q.shape
    nb = S // Q_BLOCK
    qb = q.reshape(B, nb, Q_BLOCK, H, 2, d).transpose(1, 0, 2, 3, 4, 5)
    k_pos = jnp.arange(S)
    scale = DA_QK_DIM ** -0.5

    def block(args):
        q_blk, i = args
        q_pos = i * Q_BLOCK + jnp.arange(Q_BLOCK)
        s = jnp.einsum('bqhcd,bkhcd->bhcqk', q_blk, k) * scale
        causal = k_pos[None, :] <= q_pos[:, None]
        s = jnp.where(causal, s, MASK_VALUE)
        p = jax.nn.softmax(s, axis=-1)
        a = p[:, :, 0] - lam * p[:, :, 1]
        return jnp.einsum('bhqk,bkhe->bqhe', a, v)

    o = lax.map(block, (qb, jnp.arange(nb)))
    return o.transpose(1, 0, 2, 3, 4).reshape(B, S, H, v.shape[-1])


def retention_chunkwise(q, k, v, log_gamma):
    B, S, H, dk = q.shape
    dv = v.shape[-1]
    C = RET_CHUNK
    nc = S // C

    def to_chunks(t):
        return t.reshape(B, nc, C, H, t.shape[-1]).transpose(1, 0, 3, 2, 4)

    idx = jnp.arange(C, dtype=jnp.float32)
    lg = log_gamma[:, None, None]
    rel = idx[:, None] - idx[None, :]
    decay = jnp.where(rel >= 0, jnp.exp(lg * jnp.maximum(rel, 0.0)), 0.0)
    xi = jnp.exp(log_gamma[:, None] * (idx + 1.0))[None, :, :, None]
    zeta = jnp.exp(log_gamma[:, None] * (C - 1.0 - idx))[None, :, :, None]
    gamma_c = jnp.exp(log_gamma * C)[None, :, None, None]

    def step(state, chunk):
        qc, kc, vc = chunk
        scores = jnp.einsum('bhnd,bhmd->bhnm', qc, kc) * decay[None]
        inner = jnp.einsum('bhnm,bhme->bhne', scores, vc)
        cross = jnp.einsum('bhnd,bhde->bhne', qc, state) * xi
        new_state = gamma_c * state + jnp.einsum('bhmd,bhme->bhde', kc * zeta, vc)
        return new_state, inner + cross

    state0 = jnp.zeros((B, H, dk, dv), jnp.float32)
    _, out = lax.scan(step, state0, (to_chunks(q), to_chunks(k), to_chunks(v)))
    return out.transpose(1, 0, 3, 2, 4).reshape(B, S, H, dv)


def hybrid_layer(x, cos_da, sin_da, cos_rt, sin_rt, log_gamma, layer_idx,
                 norm1_w, w_in, q_norm_w, k_norm_w, lambda_q1, lambda_k1, lambda_q2, lambda_k2,
                 da_subln_w, w_da_branch, ret_gn_w, w_ret_branch, w_out,
                 norm2_w, w_mlp_in, w_mlp_out):
    B, S, _ = x.shape
    dt = x.dtype
    h = rms_norm(x, norm1_w, NORM_EPS).astype(dt)
    proj = h @ w_in
    dq, dk, dv, rq, rk, rv, rg, gl = jnp.split(proj, SPLIT_POINTS, axis=-1)

    lambda_init = 0.8 - 0.6 * float(np.exp(-0.3 * layer_idx))
    qa = rms_norm(dq.reshape(B, S, DA_HEADS, 2, DA_QK_DIM), q_norm_w, NORM_EPS)
    ka = rms_norm(dk.reshape(B, S, DA_HEADS, 2, DA_QK_DIM), k_norm_w, NORM_EPS)
    qa = jnp.concatenate([rotate_half(qa[..., :DA_ROT_DIM], cos_da, sin_da), qa[..., DA_ROT_DIM:]], axis=-1)
    ka = jnp.concatenate([rotate_half(ka[..., :DA_ROT_DIM], cos_da, sin_da), ka[..., DA_ROT_DIM:]], axis=-1)
    va = dv.reshape(B, S, DA_HEADS, DA_V_DIM).astype(jnp.float32)
    lam = (jnp.exp(jnp.sum(lambda_q1.astype(jnp.float32) * lambda_k1.astype(jnp.float32)))
           - jnp.exp(jnp.sum(lambda_q2.astype(jnp.float32) * lambda_k2.astype(jnp.float32)))
           + lambda_init)
    oa = diff_attention(qa, ka, va, lam)
    oa = rms_norm(oa, da_subln_w, SUBLN_EPS) * (1.0 - lambda_init)
    y_a = oa.reshape(B, S, DA_V_W).astype(dt) @ w_da_branch

    qr = rotate_half(rq.reshape(B, S, RET_HEADS, RET_QK_DIM).astype(jnp.float32), cos_rt, sin_rt)
    kr = rotate_half(rk.reshape(B, S, RET_HEADS, RET_QK_DIM).astype(jnp.float32), cos_rt, sin_rt)
    kr = kr * (RET_QK_DIM ** -0.5)
    vr = rv.reshape(B, S, RET_HEADS, RET_V_DIM).astype(jnp.float32)
    orr = retention_chunkwise(qr, kr, vr, log_gamma)
    mu = jnp.mean(orr, axis=-1, keepdims=True)
    var = jnp.mean(jnp.square(orr - mu), axis=-1, keepdims=True)
    orr = (orr - mu) * lax.rsqrt(var + GN_EPS) * ret_gn_w.astype(jnp.float32).reshape(RET_HEADS, RET_V_DIM)
    orr = jax.nn.silu(rg.astype(jnp.float32)) * orr.reshape(B, S, RET_V_W)
    y_r = orr.astype(dt) @ w_ret_branch

    g_a, g_r = jnp.split(gl, N_BRANCH, axis=-1)
    merged = jax.nn.sigmoid(g_a) * y_a + jax.nn.sigmoid(g_r) * y_r
    x = x + (merged.astype(dt) @ w_out)

    h2 = rms_norm(x, norm2_w, NORM_EPS).astype(dt)
    x = x + (jnp.square(jax.nn.relu(h2 @ w_mlp_in)) @ w_mlp_out).astype(dt)
    return x


def setup_inputs(seed: int = 0) -> dict:
    key = jax.random.key(seed)
    ks = jax.random.split(key, 20)
    f32 = jnp.float32

    def nrm(k, shape, scale):
        return jax.random.normal(k, shape, f32) * scale

    def gain(k, shape):
        return 1.0 + 0.02 * jax.random.normal(k, shape, f32)

    x = jax.random.normal(ks[0], (BATCH, SEQ, D_MODEL), f32)
    offsets = jax.random.randint(ks[1], (BATCH, 1), 0, 4096, dtype=jnp.int32)
    positions = (offsets + jnp.arange(SEQ, dtype=jnp.int32)[None, :]).astype(jnp.int32)
    return {
        "x": x,
        "positions": positions,
        "norm1_w": gain(ks[2], (DEPTH, D_MODEL)),
        "w_in": nrm(ks[3], (DEPTH, D_MODEL, IN_W), D_MODEL ** -0.5),
        "q_norm_w": gain(ks[4], (DEPTH, DA_QK_DIM)),
        "k_norm_w": gain(ks[5], (DEPTH, DA_QK_DIM)),
        "lambda_q1": nrm(ks[6], (DEPTH, DA_QK_DIM), 0.1),
        "lambda_k1": nrm(ks[7], (DEPTH, DA_QK_DIM), 0.1),
        "lambda_q2": nrm(ks[8], (DEPTH, DA_QK_DIM), 0.1),
        "lambda_k2": nrm(ks[9], (DEPTH, DA_QK_DIM), 0.1),
        "da_subln_w": gain(ks[10], (DEPTH, DA_V_DIM)),
        "w_da_branch": nrm(ks[11], (DEPTH, DA_V_W, D_MODEL), DA_V_W ** -0.5),
        "ret_gn_w": gain(ks[12], (DEPTH, RET_V_W)),
        "w_ret_branch": nrm(ks[13], (DEPTH, RET_V_W, D_MODEL), RET_V_W ** -0.5),
        "w_out": nrm(ks[14], (DEPTH, D_MODEL, D_MODEL), D_MODEL ** -0.5),
        "norm2_w": gain(ks[15], (DEPTH, D_MODEL)),
        "w_mlp_in": nrm(ks[16], (DEPTH, D_MODEL, D_FF), D_MODEL ** -0.5),
        "w_mlp_out": nrm(ks[17], (DEPTH, D_FF, D_MODEL), D_FF ** -0.5),
    }


def reference(x, positions, norm1_w, w_in, q_norm_w, k_norm_w, lambda_q1, lambda_k1,
              lambda_q2, lambda_k2, da_subln_w, w_da_branch, ret_gn_w, w_ret_branch,
              w_out, norm2_w, w_mlp_in, w_mlp_out):
    pos = positions.astype(jnp.float32)[..., None]
    inv_freq_da = ROPE_THETA ** (-jnp.arange(0, DA_ROT_DIM, 2, dtype=jnp.float32) / DA_ROT_DIM)
    ang_da = (pos * inv_freq_da)[:, :, None, None, :]
    cos_da, sin_da = jnp.cos(ang_da), jnp.sin(ang_da)
    inv_freq_rt = 1.0 / (RET_THETA_BASE ** jnp.linspace(0.0, 1.0, RET_QK_DIM // 2, dtype=jnp.float32))
    ang_rt = (pos * inv_freq_rt)[:, :, None, :]
    cos_rt, sin_rt = jnp.cos(ang_rt), jnp.sin(ang_rt)
    log_gamma = jnp.log1p(-jnp.exp2(-5.0 - jnp.arange(RET_HEADS, dtype=jnp.float32)))

    for l in range(DEPTH):
        x = hybrid_layer(x, cos_da, sin_da, cos_rt, sin_rt, log_gamma, l,
                         norm1_w[l], w_in[l], q_norm_w[l], k_norm_w[l],
                         lambda_q1[l], lambda_k1[l], lambda_q2[l], lambda_k2[l],
                         da_subln_w[l], w_da_branch[l], ret_gn_w[l], w_ret_branch[l],
                         w_out[l], norm2_w[l], w_mlp_in[l], w_mlp_out[l])
    return x
```

```cpp
#include <hip/hip_runtime.h>
#include <cstdio>
#include <cstdint>
#include <cmath>
namespace pg8 {
#define PG8_LAS __attribute__((address_space(3)))
typedef unsigned short bf16_t;
typedef short bf16x8 __attribute__((ext_vector_type(8)));
typedef float f32x4 __attribute__((ext_vector_type(4)));
typedef unsigned u32x4 __attribute__((ext_vector_type(4)));
constexpr int BM = 256, BK = 64, HALF = 128, HTB = HALF * BK * 2  , STAGE_BYTES = 8 * HTB, NXCD = 8, WGM = 8;

__host__ __device__ __forceinline__ int lds_byte(int r, int c) { const int st = (r >> 4) * 2 + (c >> 5), rr = r & 15, cc = c & 31, ob = rr * 64 + cc * 2; return st * 1024 + (ob ^ (((ob >> 9) & 1) << 5)); }
__host__ __device__ __forceinline__ void stage_rc(int b, int& R, int& C) { const int st = b / 1024, sb = b % 1024, swz = sb ^ (((sb >> 9) & 1) << 5); R = (st >> 1) * 16 + swz / 64; C = (st & 1) * 32 + (swz % 64) / 2; }
__host__ __device__ __forceinline__ int perm32(int rho) { const int n = rho >> 4, i = rho & 15; return 8 * (i >> 2) + 4 * n + (i & 3); }

struct Unit { int pm, pn; };
struct Gemm { const bf16_t* A; const bf16_t* Bt; int M, N, K; };

struct StaticOrder {
    int nM, nN, nwg, G, c;
    __host__ __device__ void init(int M, int N, int G_, int c_) { nM = M / BM; nN = N / BM; nwg = nM * nN; G = G_; c = c_; }
    __host__ __device__ bool next(int i, Unit& u) const {
        const long L = (long)i * G + c; if (L >= nwg) return false;
        int wgid = (int)L; { const int q = nwg / NXCD, r = nwg % NXCD, xcd = wgid % NXCD, off = wgid / NXCD; wgid = (xcd < r ? xcd * (q + 1) : r * (q + 1) + (xcd - r) * q) + off; }
        const int nig = WGM * nN, gid = wgid / nig, fm = gid * WGM, gsz = (nM - fm) < WGM ? (nM - fm) : WGM;
        u.pm = fm + ((wgid % nig) % gsz); u.pn = (wgid % nig) / gsz; return true;
    }
    __device__ __forceinline__ void a_ready(const Unit&) const {}
    __device__ __forceinline__ void done(const Unit&) const {}
};

__device__ __forceinline__ unsigned cvt_pk_bf16(float lo, float hi) { unsigned r; asm volatile("v_cvt_pk_bf16_f32 %0, %1, %2" : "=v"(r) : "v"(lo), "v"(hi)); return r; }
typedef float f32x2 __attribute__((ext_vector_type(2)));
template <class Epi, class Sched, bool ALIGN_EPI = false, bool SP2 = false>
__device__ __forceinline__ void gemm_phase(PG8_LAS unsigned char* lds, const Gemm g, const Sched& S, const Epi& E) {
    const int tid = threadIdx.x, wid = __builtin_amdgcn_readfirstlane(tid >> 6), lane = tid & 63, wr = wid >> 2, wc = wid & 3, fr = lane & 15, fq = lane >> 4;
    const int K = g.K, nt = K / BK;
    unsigned voffA[2], voffB[2];
#pragma unroll
    for (int i = 0; i < 2; ++i) { int R, C; stage_rc(tid * 16 + i * 8192, R, C); const int Rb = Epi::PERM ? ((R & ~31) + perm32(R & 31)) : R;
        voffA[i] = (unsigned)(R * K + C) * 2u; voffB[i] = (unsigned)(Rb * K + C) * 2u; }
    const size_t kstep = (size_t)(BK * 2);
    const size_t hstep = (size_t)HALF * K * 2;
    const size_t tstep = 2 * hstep;
    const unsigned ldsw = (unsigned)wid * 1024u;
    const int aoff = lds_byte(wr * 64 + fr, fq * 8), boff = lds_byte(wc * 32 + fr, fq * 8);
#define PG8_SA(b, h) (((b) * 2 + (h)) * HTB)
#define PG8_SB(b, h) ((4 + (b) * 2 + (h)) * HTB)
#define PG8_STAGE(bufoff, gbase, voff) do { _Pragma("unroll") for (int _i = 0; _i < 2; ++_i) \
        __builtin_amdgcn_global_load_lds((const unsigned*)((const char*)(gbase) + (voff)[_i]), (PG8_LAS unsigned*)(lds + (bufoff) + ldsw + _i * 8192), 16, 0, 0); } while (0)
#define PG8_LDA(dst, b, h) do { _Pragma("unroll") for (int m = 0; m < 4; ++m) _Pragma("unroll") for (int k = 0; k < 2; ++k) dst[m][k] = *(const PG8_LAS bf16x8*)(lds + PG8_SA(b, h) + aoff + m * 2048 + k * 1024); } while (0)
#define PG8_LDB(dst, b, h) do { _Pragma("unroll") for (int n = 0; n < 2; ++n) _Pragma("unroll") for (int k = 0; k < 2; ++k) dst[n][k] = *(const PG8_LAS bf16x8*)(lds + PG8_SB(b, h) + boff + n * 2048 + k * 1024); } while (0)
#define PG8_MMA(ai, bj, At, Bt) do { __builtin_amdgcn_s_setprio(1); _Pragma("unroll") for (int m = 0; m < 4; ++m) _Pragma("unroll") for (int n = 0; n < 2; ++n) _Pragma("unroll") for (int k = 0; k < 2; ++k) \
        acc[ai][bj][m][n] = __builtin_amdgcn_mfma_f32_16x16x32_bf16(Bt[n][k], At[m][k], acc[ai][bj][m][n], 0, 0, 0); __builtin_amdgcn_s_setprio(0); } while (0)
#define PG8_WAIT_V(n) asm volatile("s_waitcnt vmcnt(" #n ")" ::: "memory")
#define PG8_WAIT_L(n) asm volatile("s_waitcnt lgkmcnt(" #n ")" ::: "memory")
#define PG8_BAR __builtin_amdgcn_s_barrier()
#define PG8_SCHED __builtin_amdgcn_sched_barrier(0)
    Unit cur, nxt; int ui = 0;
    if (!S.next(0, cur)) return;
    f32x4 acc[2][2][4][2];
#pragma unroll
    for (int a = 0; a < 2; ++a)
#pragma unroll
        for (int b = 0; b < 2; ++b)
#pragma unroll
            for (int m = 0; m < 4; ++m)
#pragma unroll
                for (int n = 0; n < 2; ++n) acc[a][b][m][n] = (f32x4){0.f, 0.f, 0.f, 0.f};
    bf16x8 At[4][2], B0[2][2], B1[2][2];
    const char* cA = (const char*)g.A + (size_t)cur.pm * tstep; const char* cB = (const char*)g.Bt + (size_t)cur.pn * tstep;
    S.a_ready(cur);
    if constexpr (SP2) {
        PG8_STAGE(PG8_SB(0, 0), cB, voffB); PG8_STAGE(PG8_SB(0, 1), cB + hstep, voffB); PG8_STAGE(PG8_SA(0, 0), cA, voffA); PG8_STAGE(PG8_SA(0, 1), cA + hstep, voffA);
        if (wr == 1) PG8_BAR;
        PG8_WAIT_V(2); PG8_BAR;
        PG8_STAGE(PG8_SB(1, 0), cB + kstep, voffB); PG8_STAGE(PG8_SA(1, 0), cA + kstep, voffA); PG8_STAGE(PG8_SB(1, 1), cB + hstep + kstep, voffB);
        PG8_WAIT_V(6); PG8_BAR;
    } else {
        PG8_STAGE(PG8_SB(0, 0), cB, voffB); PG8_STAGE(PG8_SA(0, 0), cA, voffA); PG8_STAGE(PG8_SB(0, 1), cB + hstep, voffB); PG8_STAGE(PG8_SA(0, 1), cA + hstep, voffA);
        if (wr == 1) PG8_BAR;
        PG8_WAIT_V(4); PG8_BAR;
        PG8_STAGE(PG8_SB(1, 0), cB + kstep, voffB); PG8_STAGE(PG8_SA(1, 0), cA + kstep, voffA); PG8_STAGE(PG8_SB(1, 1), cB + hstep + kstep, voffB);
        PG8_WAIT_V(6); PG8_BAR;
    }
    for (;;) {
        const bool has_next = S.next(ui + 1, nxt);
        const char* nA = has_next ? (const char*)g.A + (size_t)nxt.pm * tstep : cA; const char* nB = has_next ? (const char*)g.Bt + (size_t)nxt.pn * tstep : cB;
        for (int t = 0; t < nt; t += 2) {
            const bool last = (t == nt - 2);
            const char* a1 = cA + (size_t)(t + 1) * kstep;
            const char* a2 = last ? nA : cA + (size_t)(t + 2) * kstep; const char* b2 = last ? nB : cB + (size_t)(t + 2) * kstep;
            const char* a3 = a2 + kstep; const char* b3 = b2 + kstep;
            if (last && has_next) S.a_ready(nxt);
            if constexpr (SP2) {
            PG8_LDB(B0, 0, 0); PG8_LDB(B1, 0, 1); PG8_SCHED; PG8_LDA(At, 0, 0); PG8_STAGE(PG8_SA(1, 1), a1 + hstep, voffA);
            PG8_WAIT_V(8); PG8_WAIT_L(0); PG8_BAR; PG8_MMA(0, 0, At, B0); PG8_MMA(0, 1, At, B1); PG8_BAR; PG8_SCHED;
            PG8_LDA(At, 0, 1); PG8_STAGE(PG8_SB(0, 0), b2, voffB); PG8_STAGE(PG8_SB(0, 1), b2 + hstep, voffB); PG8_STAGE(PG8_SA(0, 0), a2, voffA);
            PG8_WAIT_V(8); PG8_WAIT_L(0); PG8_BAR; PG8_MMA(1, 0, At, B0); PG8_MMA(1, 1, At, B1); PG8_BAR; PG8_SCHED;
            PG8_LDB(B0, 1, 0); PG8_LDB(B1, 1, 1); PG8_SCHED; PG8_LDA(At, 1, 0); PG8_STAGE(PG8_SA(0, 1), a2 + hstep, voffA);
            PG8_WAIT_V(8); PG8_WAIT_L(0); PG8_BAR; PG8_MMA(0, 0, At, B0); PG8_MMA(0, 1, At, B1); PG8_BAR; PG8_SCHED;
            PG8_LDA(At, 1, 1); PG8_STAGE(PG8_SB(1, 0), b3, voffB); PG8_STAGE(PG8_SB(1, 1), b3 + hstep, voffB); PG8_STAGE(PG8_SA(1, 0), a3, voffA);
            PG8_WAIT_V(8); PG8_WAIT_L(0); PG8_BAR; PG8_MMA(1, 0, At, B0); PG8_MMA(1, 1, At, B1); PG8_BAR; PG8_SCHED;
            } else {
            PG8_LDB(B0, 0, 0); PG8_SCHED; PG8_LDA(At, 0, 0); PG8_STAGE(PG8_SA(1, 1), a1 + hstep, voffA);
            PG8_WAIT_L(8); PG8_BAR; PG8_WAIT_L(0); PG8_MMA(0, 0, At, B0); PG8_BAR; PG8_SCHED;
            PG8_LDB(B1, 0, 1); PG8_STAGE(PG8_SB(0, 0), b2, voffB);
            PG8_BAR; PG8_WAIT_L(0); PG8_MMA(0, 1, At, B1); PG8_BAR;
            PG8_LDA(At, 0, 1); PG8_STAGE(PG8_SA(0, 0), a2, voffA);
            PG8_BAR; PG8_WAIT_L(0); PG8_MMA(1, 0, At, B0); PG8_BAR; PG8_SCHED;
            PG8_STAGE(PG8_SB(0, 1), b2 + hstep, voffB);
            PG8_WAIT_V(6); PG8_BAR; PG8_MMA(1, 1, At, B1); PG8_BAR;
            PG8_LDB(B0, 1, 0); PG8_SCHED; PG8_LDA(At, 1, 0); PG8_STAGE(PG8_SA(0, 1), a2 + hstep, voffA);
            PG8_WAIT_L(8); PG8_BAR; PG8_WAIT_L(0); PG8_MMA(0, 0, At, B0); PG8_BAR; PG8_SCHED;
            PG8_LDB(B1, 1, 1); PG8_STAGE(PG8_SB(1, 0), b3, voffB);
            PG8_BAR; PG8_WAIT_L(0); PG8_MMA(0, 1, At, B1); PG8_BAR;
            PG8_LDA(At, 1, 1); PG8_STAGE(PG8_SA(1, 0), a3, voffA);
            PG8_BAR; PG8_WAIT_L(0); PG8_MMA(1, 0, At, B0); PG8_BAR; PG8_SCHED;
            PG8_STAGE(PG8_SB(1, 1), b3 + hstep, voffB);
            PG8_WAIT_V(6); PG8_BAR; PG8_MMA(1, 1, At, B1); PG8_BAR;
            }
        }
        if constexpr (ALIGN_EPI) { if (wr == 0) PG8_BAR; }
        if constexpr (!Epi::AFTER_DRAIN) { E(acc, cur, wr, wc, fr, fq); S.done(cur); }
        if (!has_next) break;
#pragma unroll
        for (int a = 0; a < 2; ++a)
#pragma unroll
            for (int b = 0; b < 2; ++b)
#pragma unroll
                for (int m = 0; m < 4; ++m)
#pragma unroll
                    for (int n = 0; n < 2; ++n) acc[a][b][m][n] = (f32x4){0.f, 0.f, 0.f, 0.f};
        cur = nxt; cA = nA; cB = nB; ++ui;
        if constexpr (ALIGN_EPI) { if (wr == 1) PG8_BAR; }
    }
    PG8_WAIT_V(0);
    if constexpr (!ALIGN_EPI) { if (wr == 0) PG8_BAR; }
    PG8_BAR;
    if constexpr (Epi::AFTER_DRAIN) { E.fused(acc, cur, wr, wc, fr, fq, lds, wid, lane); S.done(cur); }
#undef PG8_SA
#undef PG8_SB
#undef PG8_STAGE
#undef PG8_LDA
#undef PG8_LDB
#undef PG8_MMA
#undef PG8_WAIT_V
#undef PG8_WAIT_L
#undef PG8_BAR
#undef PG8_SCHED
}
}
#define GAS __attribute__((address_space(1)))
#define LAS __attribute__((address_space(3)))
typedef unsigned short bf16;
typedef unsigned v4u __attribute__((ext_vector_type(4)));
typedef float f32x4 __attribute__((ext_vector_type(4)));
typedef short bf16x8 __attribute__((ext_vector_type(8)));
typedef GAS unsigned gu32;
typedef GAS unsigned long long gu64;
#define RLX_AGENT __ATOMIC_RELAXED, __HIP_MEMORY_SCOPE_AGENT
#define LDS_WAIT() asm volatile("s_waitcnt lgkmcnt(0)" ::: "memory")
#define VM_WAIT() asm volatile("s_waitcnt vmcnt(0)" ::: "memory")
__device__ __forceinline__ unsigned long long rt() { return __builtin_amdgcn_s_memrealtime(); }
__device__ __forceinline__ unsigned f2bf(float f) { unsigned u = __builtin_bit_cast(unsigned, f); return (u + 0x7fffu + ((u >> 16) & 1u)) >> 16; }
__device__ __forceinline__ unsigned pk2(float lo, float hi) { return f2bf(lo) | (f2bf(hi) << 16); }

#define XB_TMO      128
#define XB_XCNT(j)  (256  + 64 * (j))
#define XB_XSUB(j)  (1280 + 64 * (j))
#define XB_XGEN(j)  (2304 + 64 * (j))
#define XB_TOP      3328
#define XB_TOPGEN   3392
#define XCD_BAR_WORDS 3456
#define XB_SPIN_CAP (1u << 18)

__device__ __forceinline__ unsigned xb_ld(unsigned* p)              { return __hip_atomic_load(p, __ATOMIC_RELAXED, __HIP_MEMORY_SCOPE_AGENT); }
__device__ __forceinline__ unsigned xb_add(unsigned* p, unsigned v) { return __hip_atomic_fetch_add(p, v, __ATOMIC_RELAXED, __HIP_MEMORY_SCOPE_AGENT); }
__device__ __forceinline__ unsigned xb_xcc_id() { return (unsigned)__builtin_amdgcn_s_getreg((3 << 11) | 20) & 0xFu; }
#define XB_SPIN(cond, bar) do { unsigned _sp = 0; while (cond) { __builtin_amdgcn_s_sleep(1); \
    if ((++_sp & 255u) == 0u) { if (xb_ld(&(bar)[XB_TMO])) break; if (_sp > XB_SPIN_CAP) { atomicAdd(&(bar)[XB_TMO], 1u); break; } } } } while (0)

struct XcdBarrier {
    unsigned* bar; unsigned x;
    volatile LAS unsigned* st;
};

__device__ __forceinline__ XcdBarrier xcd_barrier_post(unsigned* bar, volatile LAS unsigned* st) {
    XcdBarrier b; b.bar = bar; b.x = xb_xcc_id(); b.st = st;
    if (threadIdx.x == 0) (void)xb_add(&bar[XB_XCNT(b.x)], 1u);
    return b;
}
__device__ __forceinline__ void xcd_barrier_complete(unsigned* bar, unsigned x, unsigned& nloc, unsigned& nx) {
    const unsigned G = gridDim.x * gridDim.y * gridDim.z;
    unsigned sum, cnt, mine, sp = 0u;
    for (;;) {
        sum = 0u; cnt = 0u; mine = 0u;
#pragma unroll
        for (unsigned j = 0; j < 16; ++j) { const unsigned c = xb_ld(&bar[XB_XCNT(j)]); sum += c; cnt += (c > 0u) ? 1u : 0u; mine = (j == x) ? c : mine; }
        if (sum == G) break;
        __builtin_amdgcn_s_sleep(1);
        if ((++sp & 255u) == 0u) { if (xb_ld(&bar[XB_TMO])) break; if (sp > XB_SPIN_CAP) { atomicAdd(&bar[XB_TMO], 1u); break; } }
    }
    nloc = mine > 0u ? mine : 1u; nx = cnt > 0u ? cnt : 1u;
}

__device__ __forceinline__ void xcd_barrier(const XcdBarrier& b) {
    asm volatile("s_waitcnt vmcnt(0)" ::: "memory");
    __syncthreads();
    if (threadIdx.x == 0) {
        unsigned* bar = b.bar;
        __builtin_amdgcn_s_waitcnt(0);
        unsigned nloc = b.st[0], nx = b.st[1];
        if (nloc == 0u) { xcd_barrier_complete(bar, b.x, nloc, nx); b.st[0] = nloc; b.st[1] = nx; }
        const unsigned old = xb_add(&bar[XB_XSUB(b.x)], 1u);
        const unsigned gen = old / nloc;
        if (old + 1u == (gen + 1u) * nloc) {
            __builtin_amdgcn_fence(__ATOMIC_RELEASE, "agent");
            asm volatile("s_waitcnt vmcnt(0)" ::: "memory");
            const unsigned og = xb_add(&bar[XB_TOP], 1u);
            const unsigned tg = og / nx;
            if (og + 1u == (tg + 1u) * nx) xb_add(&bar[XB_TOPGEN], 1u);
            else XB_SPIN(xb_ld(&bar[XB_TOPGEN]) == tg, bar);
            __builtin_amdgcn_fence(__ATOMIC_ACQUIRE, "agent");
            xb_add(&bar[XB_XGEN(b.x)], 1u);
            asm volatile("s_waitcnt vmcnt(0)" ::: "memory");
        } else {
            XB_SPIN(xb_ld(&bar[XB_XGEN(b.x)]) == gen, bar);
            __builtin_amdgcn_fence(__ATOMIC_ACQUIRE, "agent");
            asm volatile("s_waitcnt vmcnt(0)" ::: "memory");
        }
    }
    __syncthreads();
}

constexpr int NWAVES = 8;
constexpr int BATCH = 8, SEQ = 4096, DM = 1024, M = BATCH * SEQ, INW = 6656, FF = 4096;
constexpr int NFREQ = 72;
constexpr float C2 = 0.125f * 1.4426950408889634f;
constexpr float KR_SCALE = 0.08838834764831845f;
constexpr float LAMBDA_INIT = 0.2f;
constexpr int N_PHASES = 8;
#ifndef MK_N_LAUNCHES
#define MK_N_LAUNCHES 8
#endif

constexpr size_t MiB = 1u << 20;
constexpr size_t WS_CTL = 0, CTL_ZERO_BYTES = 1 * MiB;
constexpr size_t WS_WIN = 2 * MiB, WS_WA = 15 * MiB, WS_WR = 16 * MiB, WS_WO = 18 * MiB, WS_W1 = 20 * MiB, WS_W2 = 28 * MiB;
constexpr size_t WS_CS = 36 * MiB;
constexpr size_t WS_RSS = 54 * MiB;
constexpr size_t WS_MISC = 56 * MiB;
constexpr size_t WS_XN = 64 * MiB;
constexpr size_t WS_QD = 128 * MiB, WS_KD = 160 * MiB, WS_VD = 192 * MiB, WS_QR = 224 * MiB, WS_KR = 256 * MiB;
constexpr size_t WS_VR = 288 * MiB, WS_GS = 352 * MiB;
constexpr size_t WS_OA = 416 * MiB;
constexpr size_t WS_ORR = 448 * MiB;
constexpr size_t WS_TMP = 128 * MiB, WS_MRG = 192 * MiB;
constexpr size_t WS_HID = 128 * MiB;
constexpr size_t WS_ORAW = WS_XN;
constexpr size_t WS_END = 512 * MiB;
constexpr int CW_BAR = 4096;

constexpr int RING_BYTES = 131072;
constexpr int LDS_BYTES = 163840;
constexpr int MISC_OFF = LDS_BYTES - 256;

struct Frame {
    LAS unsigned char* lds;
    volatile LAS unsigned* MISC;
    gu32* ctl;
    int tid, lane, wave, G;
    unsigned char* ws;
};
struct Args { const void* in[18]; float* out; unsigned char* ws; double invf[NFREQ]; int ph_lo, ph_hi, li, pad; };

__device__ __forceinline__ float wave_sum(float v) {
#pragma unroll
    for (int o = 1; o < 64; o <<= 1) v += __shfl_xor(v, o);
    return v;
}
__device__ __forceinline__ float bf2f(unsigned short h) { return __builtin_bit_cast(float, (unsigned)h << 16); }
__device__ __forceinline__ float bflo(unsigned w) { return __builtin_bit_cast(float, w << 16); }
__device__ __forceinline__ float bfhi(unsigned w) { return __builtin_bit_cast(float, w & 0xffff0000u); }

__host__ __device__ __forceinline__ int da_dim(int bj, int i, int fq) {
    if (bj == 0 && i < 4) return (i & 1) + 2 * fq + 8 * (i >> 1);
    const int idx = bj == 0 ? i - 4 : 4 + i; return 16 + 12 * fq + idx;
}
__host__ __device__ __forceinline__ int win_col(int p) {
    const int pn = p >> 8, t = p & 255, bj = t >> 7, wc = (t >> 5) & 3, fq = (t >> 3) & 3, i = t & 7;
    if (pn < 4) { const int G = 4 * (pn & 1) + wc; return (pn >> 1) * 512 + 64 * G + da_dim(bj, i, fq); }
    if (pn >= 6 && pn < 10) { const int head = 2 * (pn & 1) + (wc >> 1); return 1536 + ((pn - 6) >> 1) * 512 + 128 * head + 64 * bj + 32 * (wc & 1) + 8 * fq + i; }
    return p;
}

template <bool PERMUTE>
__device__ __forceinline__ void p0_transpose_item(const float* W, int K, int N, bf16* WT, LAS float* scr, int item, int lane, const float* kscale) {
    const int nblk = N / 32, kb = item / nblk, nb = item % nblk, k0 = 64 * kb, n0 = 32 * nb;
    const int col = PERMUTE ? win_col(n0 + (lane & 31)) : n0 + (lane & 31);
#pragma unroll 8
    for (int i = 0; i < 32; ++i) { const int kk = 2 * i + (lane >> 5); float v = W[(size_t)(k0 + kk) * N + col]; if (kscale) v *= kscale[k0 + kk]; scr[kk * 33 + (lane & 31)] = v; }
    LDS_WAIT(); asm volatile("" ::: "memory");
    const int c = lane & 7;
#pragma unroll
    for (int j = 0; j < 4; ++j) { const int n = (lane >> 3) + 8 * j; const LAS float* s = scr + (8 * c) * 33 + n;
        v4u o; o.x = pk2(s[0 * 33], s[1 * 33]); o.y = pk2(s[2 * 33], s[3 * 33]); o.z = pk2(s[4 * 33], s[5 * 33]); o.w = pk2(s[6 * 33], s[7 * 33]);
        *(GAS v4u*)(WT + (size_t)(n0 + n) * K + k0 + 8 * c) = o; }
    LDS_WAIT(); asm volatile("" ::: "memory");
}
__device__ __forceinline__ void p0_prologue(Frame& F, const Args& A) {
    const float* x = (const float*)A.in[0]; const int* pos = (const int*)A.in[1]; const float* n1w = (const float*)A.in[2];
    LAS float* scr = (LAS float*)(F.lds + F.wave * 16384);
    const int gw = blockIdx.x * NWAVES + F.wave, NGW = F.G * NWAVES;
    constexpr int I_IN = (DM / 64) * (INW / 32), I_A = (512 / 64) * (DM / 32), I_R = (DM / 64) * (DM / 32), I_O = I_R, I_1 = (DM / 64) * (FF / 32), I_2 = (FF / 64) * (DM / 32);
    constexpr int NITEMS = I_IN + I_A + I_R + I_O + I_1 + I_2;
    for (int it = gw; it < NITEMS; it += NGW) {
        int r = it;
        if (r < I_IN) { p0_transpose_item<true>((const float*)A.in[3], DM, INW, (bf16*)(F.ws + WS_WIN), scr, r, F.lane, nullptr); continue; } r -= I_IN;
        if (r < I_A) { p0_transpose_item<false>((const float*)A.in[11], 512, DM, (bf16*)(F.ws + WS_WA), scr, r, F.lane, nullptr); continue; } r -= I_A;
        if (r < I_R) { p0_transpose_item<false>((const float*)A.in[13], DM, DM, (bf16*)(F.ws + WS_WR), scr, r, F.lane, nullptr); continue; } r -= I_R;
        if (r < I_O) { p0_transpose_item<false>((const float*)A.in[14], DM, DM, (bf16*)(F.ws + WS_WO), scr, r, F.lane, nullptr); continue; } r -= I_O;
        if (r < I_1) { p0_transpose_item<false>((const float*)A.in[16], DM, FF, (bf16*)(F.ws + WS_W1), scr, r, F.lane, (const float*)A.in[15]); continue; } r -= I_1;
        p0_transpose_item<false>((const float*)A.in[17], FF, DM, (bf16*)(F.ws + WS_W2), scr, r, F.lane, nullptr);
    }
    bf16* XN = (bf16*)(F.ws + WS_XN);
    f32x4 wv[4];
#pragma unroll
    for (int j = 0; j < 4; ++j) wv[j] = ((const GAS f32x4*)n1w)[64 * j + F.lane];
    for (int m = gw; m < M; m += NGW) {
        const GAS f32x4* xr = (const GAS f32x4*)(x + (size_t)m * DM) + F.lane;
        f32x4 v[4]; float s = 0.f;
#pragma unroll
        for (int j = 0; j < 4; ++j) { v[j] = xr[64 * j]; s += (v[j].x * v[j].x + v[j].y * v[j].y) + (v[j].z * v[j].z + v[j].w * v[j].w); }
        const float rstd = 1.f / sqrtf(wave_sum(s) * (1.f / DM) + 1e-6f);
        GAS unsigned long long* o8 = (GAS unsigned long long*)(XN + (size_t)m * DM) + F.lane;
#pragma unroll
        for (int j = 0; j < 4; ++j) o8[64 * j] = (unsigned long long)pk2(v[j].x * rstd * wv[j].x, v[j].y * rstd * wv[j].y) | ((unsigned long long)pk2(v[j].z * rstd * wv[j].z, v[j].w * rstd * wv[j].w) << 32);
    }
    { typedef float f32x2v __attribute__((ext_vector_type(2)));
      GAS f32x2v* cs = (GAS f32x2v*)(F.ws + WS_CS);
      const int gt = blockIdx.x * (NWAVES * 64) + F.tid, NT = F.G * NWAVES * 64;
      for (int e = gt; e < M * NFREQ; e += NT) {
          const int t = e / NFREQ, f = e - t * NFREQ;
          const double a = (double)pos[t] * A.invf[f];
          double rev = a * 0.15915494309189535; rev -= floor(rev);
          const float xr = (float)rev;
          cs[e] = (f32x2v){__builtin_amdgcn_cosf(xr), __builtin_amdgcn_sinf(xr)};
      } }
    if (blockIdx.x == 0 && F.wave == 0) {
        const float* qn = (const float*)A.in[4]; const float* kn = (const float*)A.in[5];
        const float* l1q = (const float*)A.in[6]; const float* l1k = (const float*)A.in[7]; const float* l2q = (const float*)A.in[8]; const float* l2k = (const float*)A.in[9];
        const float s1 = wave_sum(l1q[F.lane] * l1k[F.lane]), s2 = wave_sum(l2q[F.lane] * l2k[F.lane]);
        float mq = fabsf(qn[F.lane]), mk = fabsf(kn[F.lane]);
#pragma unroll
        for (int o = 1; o < 64; o <<= 1) { mq = fmaxf(mq, __shfl_xor(mq, o)); mk = fmaxf(mk, __shfl_xor(mk, o)); }
        if (F.lane == 0) { float* misc = (float*)(F.ws + WS_MISC); misc[0] = expf(s1) - expf(s2) + LAMBDA_INIT; misc[1] = 8.0f * 1.4426950408889634f * mq * mk * 1.01f; }
    }
}

using pg8::bf16_t; using pg8::Unit; using pg8::cvt_pk_bf16;
typedef unsigned u32x4e __attribute__((ext_vector_type(4)));
__device__ __forceinline__ u32x4e pack8(const f32x4& a, const f32x4& b) { u32x4e w; w.x = cvt_pk_bf16(a[0], a[1]); w.y = cvt_pk_bf16(a[2], a[3]); w.z = cvt_pk_bf16(b[0], b[1]); w.w = cvt_pk_bf16(b[2], b[3]); return w; }
__device__ __forceinline__ float sigmoidf_(float v) { return __builtin_amdgcn_rcpf(1.0f + __builtin_amdgcn_exp2f(-1.4426950408889634f * v)); }

struct EpiProj {
    static constexpr bool PERM = true, AFTER_DRAIN = false;
    bf16_t *QD, *KD, *QR, *KR, *GATE; unsigned char* ws; const float* cs; const float* qnw; const float* knw;
    __device__ __forceinline__ void operator()(const f32x4 (&acc)[2][2][4][2], const Unit& u, int wr, int wc, int fr_, int fq_) const {
        int fr = fr_, fq = fq_; asm volatile("" : "+v"(fr), "+v"(fq));
        const int pn = u.pn, row0 = u.pm * 256 + wr * 64 + fr;
        if (pn < 4) {
            const bool isq = pn < 2; const float* nw = isq ? qnw : knw; bf16_t* dst = (isq ? QD : KD) + 64 * (4 * (pn & 1) + wc) + 8 * fq;
            const float osc = isq ? C2 : 1.0f;
            float w[2][8];
#pragma unroll
            for (int bj = 0; bj < 2; ++bj)
#pragma unroll
                for (int i = 0; i < 8; ++i) w[bj][i] = nw[da_dim(bj, i, fq)] * osc;
#pragma unroll
            for (int ai = 0; ai < 2; ++ai)
#pragma unroll
                for (int m = 0; m < 4; ++m) {
                    const int row = row0 + ai * 128 + m * 16;
                    f32x4 a0 = acc[ai][0][m][0], a1 = acc[ai][0][m][1], b0 = acc[ai][1][m][0], b1 = acc[ai][1][m][1];
                    float ss = (a0[0] * a0[0] + a0[1] * a0[1]) + (a0[2] * a0[2] + a0[3] * a0[3]) + (a1[0] * a1[0] + a1[1] * a1[1]) + (a1[2] * a1[2] + a1[3] * a1[3])
                             + (b0[0] * b0[0] + b0[1] * b0[1]) + (b0[2] * b0[2] + b0[3] * b0[3]) + (b1[0] * b1[0] + b1[1] * b1[1]) + (b1[2] * b1[2] + b1[3] * b1[3]);
                    ss += __shfl_xor(ss, 16); ss += __shfl_xor(ss, 32);
                    const float rs = 1.0f / sqrtf(ss * (1.0f / 64.0f) + 1e-6f);
#pragma unroll
                    for (int e = 0; e < 4; ++e) { a0[e] *= rs * w[0][e]; a1[e] *= rs * w[0][4 + e]; b0[e] *= rs * w[1][e]; b1[e] *= rs * w[1][4 + e]; }
                    const f32x4 c4 = *(const f32x4*)(cs + ((size_t)row * NFREQ + 2 * fq) * 2);
                    { const float t1 = a0[0], t2 = a0[2]; a0[0] = t1 * c4[0] - t2 * c4[1]; a0[2] = t1 * c4[1] + t2 * c4[0]; }
                    { const float t1 = a0[1], t2 = a0[3]; a0[1] = t1 * c4[2] - t2 * c4[3]; a0[3] = t1 * c4[3] + t2 * c4[2]; }
                    bf16_t* rp = dst + (size_t)row * 512;
                    *(u32x4e*)(rp) = pack8(a0, a1); *(u32x4e*)(rp + 32) = pack8(b0, b1);
                    asm volatile("" ::: "memory");
                }
        } else if (pn >= 6 && pn < 10) {
            const bool isq = pn < 8; const int j0 = 32 * (wc & 1) + 8 * fq;
            bf16_t* dst = (isq ? QR : KR) + 128 * (2 * (pn & 1) + (wc >> 1)) + j0;
            const float osc = isq ? 1.0f : KR_SCALE;
#pragma unroll
            for (int ai = 0; ai < 2; ++ai)
#pragma unroll
                for (int m = 0; m < 4; ++m) {
                    const int row = row0 + ai * 128 + m * 16;
                    const f32x4* cp = (const f32x4*)(cs + ((size_t)row * NFREQ + 8 + j0) * 2);
                    f32x4 t1[2] = {acc[ai][0][m][0], acc[ai][0][m][1]}, t2[2] = {acc[ai][1][m][0], acc[ai][1][m][1]}, o1[2], o2[2];
#pragma unroll
                    for (int n = 0; n < 2; ++n) { const f32x4 ca = cp[2 * n], cb = cp[2 * n + 1];
                        o1[n][0] = (t1[n][0] * ca[0] - t2[n][0] * ca[1]) * osc; o2[n][0] = (t1[n][0] * ca[1] + t2[n][0] * ca[0]) * osc;
                        o1[n][1] = (t1[n][1] * ca[2] - t2[n][1] * ca[3]) * osc; o2[n][1] = (t1[n][1] * ca[3] + t2[n][1] * ca[2]) * osc;
                        o1[n][2] = (t1[n][2] * cb[0] - t2[n][2] * cb[1]) * osc; o2[n][2] = (t1[n][2] * cb[1] + t2[n][2] * cb[0]) * osc;
                        o1[n][3] = (t1[n][3] * cb[2] - t2[n][3] * cb[3]) * osc; o2[n][3] = (t1[n][3] * cb[3] + t2[n][3] * cb[2]) * osc; }
                    bf16_t* rp = dst + (size_t)row * 512;
                    *(u32x4e*)(rp) = pack8(o1[0], o1[1]); *(u32x4e*)(rp + 64) = pack8(o2[0], o2[1]);
                    asm volatile("" ::: "memory");
                }
        } else {
            const int act = pn < 14 ? 0 : (pn < 18 ? 1 : 2);
            const int ld = pn < 6 ? 512 : (pn < 18 ? 1024 : 2048);
            const int colt = (pn < 6 ? pn - 4 : (pn < 14 ? pn - 10 : (pn < 18 ? pn - 14 : pn - 18))) * 256;
            const size_t woff = pn < 6 ? WS_VD : (pn < 14 ? WS_VR : WS_GS);
            bf16_t* dst = (pn < 18 ? (bf16_t*)(ws + woff) : GATE) + colt + wc * 32 + 8 * fq;
#pragma unroll
            for (int ai = 0; ai < 2; ++ai)
#pragma unroll
                for (int m = 0; m < 4; ++m) {
                    const int row = row0 + ai * 128 + m * 16; bf16_t* rp = dst + (size_t)row * ld;
#pragma unroll
                    for (int bj = 0; bj < 2; ++bj) { f32x4 v0 = acc[ai][bj][m][0], v1 = acc[ai][bj][m][1];
                        if (act) {
#pragma unroll
                            for (int e = 0; e < 4; ++e) { const float s0 = sigmoidf_(v0[e]), s1 = sigmoidf_(v1[e]); v0[e] = act == 1 ? v0[e] * s0 : s0; v1[e] = act == 1 ? v1[e] * s1 : s1; } }
                        *(u32x4e*)(rp + bj * 128) = pack8(v0, v1); }
                    asm volatile("" ::: "memory");
                }
        }
    }
};
template <int STAGE> struct EpiMerge {
    static constexpr bool PERM = true, AFTER_DRAIN = false;
    const bf16_t* GATE; bf16_t* TMP; bf16_t* MRG;
    __device__ __forceinline__ void operator()(const f32x4 (&acc)[2][2][4][2], const Unit& u, int wr, int wc, int fr_, int fq_) const {
        int fr = fr_, fq = fq_; asm volatile("" : "+v"(fr), "+v"(fq));
        const int row0 = u.pm * 256 + wr * 64 + fr, col0 = u.pn * 256 + wc * 32 + 8 * fq;
#pragma unroll
        for (int ai = 0; ai < 2; ++ai)
#pragma unroll
            for (int m = 0; m < 4; ++m) { const size_t row = (size_t)(row0 + ai * 128 + m * 16);
#pragma unroll
                for (int bj = 0; bj < 2; ++bj) { const int col = col0 + bj * 128;
                    const u32x4e g = *(const u32x4e*)(GATE + row * 2048 + STAGE * 1024 + col);
                    f32x4 v0 = acc[ai][bj][m][0], v1 = acc[ai][bj][m][1];
                    v0[0] *= bflo(g.x); v0[1] *= bfhi(g.x); v0[2] *= bflo(g.y); v0[3] *= bfhi(g.y); v1[0] *= bflo(g.z); v1[1] *= bfhi(g.z); v1[2] *= bflo(g.w); v1[3] *= bfhi(g.w);
                    if (STAGE == 0) { *(u32x4e*)(TMP + row * 1024 + col) = pack8(v0, v1); }
                    else { const u32x4e t = *(const u32x4e*)(TMP + row * 1024 + col);
                        v0[0] += bflo(t.x); v0[1] += bfhi(t.x); v0[2] += bflo(t.y); v0[3] += bfhi(t.y); v1[0] += bflo(t.z); v1[1] += bfhi(t.z); v1[2] += bflo(t.w); v1[3] += bfhi(t.w);
                        *(u32x4e*)(MRG + row * 1024 + col) = pack8(v0, v1); } } }
    }
};
struct EpiX1 {
    static constexpr bool PERM = true, AFTER_DRAIN = false;
    const float* x; float* out; bf16_t* XN; float* rss;
    __device__ __forceinline__ void operator()(const f32x4 (&acc)[2][2][4][2], const Unit& u, int wr, int wc, int fr_, int fq_) const {
        int fr = fr_, fq = fq_; asm volatile("" : "+v"(fr), "+v"(fq));
        const int row0 = u.pm * 256 + wr * 64 + fr, col0 = u.pn * 256 + wc * 32 + 8 * fq;
#pragma unroll
        for (int ai = 0; ai < 2; ++ai)
#pragma unroll
            for (int m = 0; m < 4; ++m) { const size_t row = (size_t)(row0 + ai * 128 + m * 16); float ss = 0.f;
#pragma unroll
                for (int bj = 0; bj < 2; ++bj) { const size_t off = row * 1024 + col0 + bj * 128;
                    const f32x4 v0 = acc[ai][bj][m][0] + *(const f32x4*)(x + off), v1 = acc[ai][bj][m][1] + *(const f32x4*)(x + off + 4);
                    *(f32x4*)(out + off) = v0; *(f32x4*)(out + off + 4) = v1; *(u32x4e*)(XN + off) = pack8(v0, v1);
                    ss += (v0[0] * v0[0] + v0[1] * v0[1]) + (v0[2] * v0[2] + v0[3] * v0[3]) + (v1[0] * v1[0] + v1[1] * v1[1]) + (v1[2] * v1[2] + v1[3] * v1[3]); }
                ss += __shfl_xor(ss, 16); ss += __shfl_xor(ss, 32);
                if (fq == 0) rss[row * 16 + u.pn * 4 + wc] = ss; }
    }
};
struct EpiHid {
    static constexpr bool PERM = true, AFTER_DRAIN = false;
    const float* rss; bf16_t* HID;
    __device__ __forceinline__ void operator()(const f32x4 (&acc)[2][2][4][2], const Unit& u, int wr, int wc, int fr_, int fq_) const {
        int fr = fr_, fq = fq_; asm volatile("" : "+v"(fr), "+v"(fq));
        const int row0 = u.pm * 256 + wr * 64 + fr, col0 = u.pn * 256 + wc * 32 + 8 * fq;
#pragma unroll
        for (int ai = 0; ai < 2; ++ai)
#pragma unroll
            for (int m = 0; m < 4; ++m) { const size_t row = (size_t)(row0 + ai * 128 + m * 16);
                const f32x4* rp = (const f32x4*)(rss + row * 16); const f32x4 r0 = rp[0], r1 = rp[1], r2 = rp[2], r3 = rp[3];
                const float ssum = ((r0[0] + r0[1]) + (r0[2] + r0[3])) + ((r1[0] + r1[1]) + (r1[2] + r1[3])) + ((r2[0] + r2[1]) + (r2[2] + r2[3])) + ((r3[0] + r3[1]) + (r3[2] + r3[3]));
                const float rs = 1.0f / sqrtf(ssum * (1.0f / 1024.0f) + 1e-6f);
#pragma unroll
                for (int bj = 0; bj < 2; ++bj) { f32x4 v0 = acc[ai][bj][m][0] * rs, v1 = acc[ai][bj][m][1] * rs;
#pragma unroll
                    for (int e = 0; e < 4; ++e) { const float a = fmaxf(v0[e], 0.f), b = fmaxf(v1[e], 0.f); v0[e] = a * a; v1[e] = b * b; }
                    *(u32x4e*)(HID + row * 4096 + col0 + bj * 128) = pack8(v0, v1); } }
    }
};
struct EpiOut {
    static constexpr bool PERM = true, AFTER_DRAIN = false;
    float* out;
    __device__ __forceinline__ void operator()(const f32x4 (&acc)[2][2][4][2], const Unit& u, int wr, int wc, int fr_, int fq_) const {
        int fr = fr_, fq = fq_; asm volatile("" : "+v"(fr), "+v"(fq));
        const int row0 = u.pm * 256 + wr * 64 + fr, col0 = u.pn * 256 + wc * 32 + 8 * fq;
#pragma unroll
        for (int ai = 0; ai < 2; ++ai)
#pragma unroll
            for (int m = 0; m < 4; ++m) { const size_t row = (size_t)(row0 + ai * 128 + m * 16);
#pragma unroll
                for (int bj = 0; bj < 2; ++bj) { float* p = out + row * 1024 + col0 + bj * 128;
                    const f32x4 v0 = acc[ai][bj][m][0] + *(const f32x4*)(p), v1 = acc[ai][bj][m][1] + *(const f32x4*)(p + 4);
                    *(f32x4*)(p) = v0; *(f32x4*)(p + 4) = v1; } }
    }
};

__device__ __forceinline__ void attn_naive_phase(Frame& F, const Args& A) {
    const bf16* QD = (const bf16*)(F.ws + WS_QD); const bf16* KD = (const bf16*)(F.ws + WS_KD); const bf16* VD = (const bf16*)(F.ws + WS_VD); bf16* OA = (bf16*)(F.ws + WS_OA);
    const float* misc = (const float*)(F.ws + WS_MISC); const float lam = misc[0], mb = misc[1];
    const float* subw = (const float*)A.in[10];
    LAS float* Qf = (LAS float*)F.lds;
    LAS float* Kf = Qf + 2 * 32 * 64;
    LAS float* Vf = Kf + 2 * 64 * 65;
    LAS float* Pf = Vf + 64 * 128;
    const int tid = F.tid, row = tid >> 4, sub = tid & 15;
    for (int item = blockIdx.x; item < BATCH * 4 * (SEQ / 32); item += F.G) {
        const int qb = item % (SEQ / 32), bh = item / (SEQ / 32), h = bh & 3, b = bh >> 2;
        const int q0 = qb * 32; const size_t tok0 = (size_t)b * SEQ;
        __syncthreads();
        { const int r = tid >> 4, c8 = (tid & 15) * 8;
          const v4u w = *(const GAS v4u*)(QD + (tok0 + q0 + r) * 512 + h * 128 + c8);
          LAS float* d = Qf + (c8 >> 6) * 2048 + r * 64 + (c8 & 63);
          d[0] = bflo(w.x); d[1] = bfhi(w.x); d[2] = bflo(w.y); d[3] = bfhi(w.y); d[4] = bflo(w.z); d[5] = bfhi(w.z); d[6] = bflo(w.w); d[7] = bfhi(w.w); }
        float o0[8], o1[8], l0 = 0.f, l1 = 0.f;
#pragma unroll
        for (int e = 0; e < 8; ++e) { o0[e] = 0.f; o1[e] = 0.f; }
        const int nkt = (q0 + 32 + 63) / 64;
        for (int kt = 0; kt < nkt; ++kt) {
            __syncthreads();
#pragma unroll
            for (int rep = 0; rep < 2; ++rep) { const int r = (tid >> 4) + 32 * rep, c8 = (tid & 15) * 8;
                const v4u w = *(const GAS v4u*)(KD + (tok0 + kt * 64 + r) * 512 + h * 128 + c8);
                LAS float* d = Kf + (c8 >> 6) * (64 * 65) + r * 65 + (c8 & 63);
                d[0] = bflo(w.x); d[1] = bfhi(w.x); d[2] = bflo(w.y); d[3] = bfhi(w.y); d[4] = bflo(w.z); d[5] = bfhi(w.z); d[6] = bflo(w.w); d[7] = bfhi(w.w);
                const v4u v = *(const GAS v4u*)(VD + (tok0 + kt * 64 + r) * 512 + h * 128 + c8);
                LAS float* dv = Vf + r * 128 + c8;
                dv[0] = bflo(v.x); dv[1] = bfhi(v.x); dv[2] = bflo(v.y); dv[3] = bfhi(v.y); dv[4] = bflo(v.z); dv[5] = bfhi(v.z); dv[6] = bflo(v.w); dv[7] = bfhi(v.w); }
            __syncthreads();
#pragma unroll
            for (int c = 0; c < 2; ++c) {
                float s[4] = {0.f, 0.f, 0.f, 0.f};
                const LAS float* qp = Qf + c * 2048 + row * 64; const LAS float* kp = Kf + c * (64 * 65) + (sub * 4) * 65;
                for (int d = 0; d < 64; ++d) { const float q = qp[d];
#pragma unroll
                    for (int kk = 0; kk < 4; ++kk) s[kk] += q * kp[kk * 65 + d]; }
#pragma unroll
                for (int kk = 0; kk < 4; ++kk) { const int key = kt * 64 + sub * 4 + kk; const float p = key <= q0 + row ? __builtin_amdgcn_exp2f(s[kk] - mb) : 0.f;
                    Pf[c * (32 * 65) + row * 65 + sub * 4 + kk] = p; if (c == 0) l0 += p; else l1 += p; }
            }
            __syncthreads();
            for (int key = 0; key < 64; ++key) { const float p0 = Pf[row * 65 + key], p1 = Pf[32 * 65 + row * 65 + key]; const LAS float* vp = Vf + key * 128 + sub * 8;
#pragma unroll
                for (int e = 0; e < 8; ++e) { o0[e] += p0 * vp[e]; o1[e] += p1 * vp[e]; } }
        }
#pragma unroll
        for (int o = 1; o < 16; o <<= 1) { l0 += __shfl_xor(l0, o); l1 += __shfl_xor(l1, o); }
        const float i0 = 1.0f / l0, i1 = lam / l1; float ov[8], ss = 0.f;
#pragma unroll
        for (int e = 0; e < 8; ++e) { ov[e] = o0[e] * i0 - o1[e] * i1; ss += ov[e] * ov[e]; }
#pragma unroll
        for (int o = 1; o < 16; o <<= 1) ss += __shfl_xor(ss, o);
        const float rs = (1.0f - LAMBDA_INIT) / sqrtf(ss * (1.0f / 128.0f) + 1e-5f);
        v4u w; w.x = pk2(ov[0] * rs * subw[sub * 8 + 0], ov[1] * rs * subw[sub * 8 + 1]); w.y = pk2(ov[2] * rs * subw[sub * 8 + 2], ov[3] * rs * subw[sub * 8 + 3]);
        w.z = pk2(ov[4] * rs * subw[sub * 8 + 4], ov[5] * rs * subw[sub * 8 + 5]); w.w = pk2(ov[6] * rs * subw[sub * 8 + 6], ov[7] * rs * subw[sub * 8 + 7]);
        *(GAS v4u*)(OA + (tok0 + q0 + row) * 512 + h * 128 + sub * 8) = w;
    }
    __syncthreads();
}

__device__ __forceinline__ void ret_naive_phase(Frame& F) {
    const bf16* QR = (const bf16*)(F.ws + WS_QR); const bf16* KR = (const bf16*)(F.ws + WS_KR); const bf16* VR = (const bf16*)(F.ws + WS_VR); bf16* ORAW = (bf16*)(F.ws + WS_ORAW);
    LAS unsigned short* Qc = (LAS unsigned short*)F.lds;
    LAS unsigned short* Kc = Qc + 128 * 128;
    LAS unsigned short* Vc = Kc + 128 * 128;
    LAS float* Sc = (LAS float*)(Vc + 128 * 32);
    LAS float* St = Sc + 128 * 128;
    const int tid = F.tid;
    for (int item = blockIdx.x; item < BATCH * 4 * 8; item += F.G) {
        const int sl = item & 7, h = (item >> 3) & 3, b = item >> 5;
        const float lg2 = log2f(1.0f - exp2f(-5.0f - (float)h));
        const float gamma_c = exp2f(lg2 * 128.0f);
        __syncthreads();
        for (int i = tid; i < 128 * 32; i += 512) St[i] = 0.f;
        for (int ch = 0; ch < SEQ / 128; ++ch) {
            const size_t tok0 = (size_t)b * SEQ + ch * 128;
            __syncthreads();
#pragma unroll
            for (int rep = 0; rep < 4; ++rep) { const int v = tid + 512 * rep, r = v >> 4, c8 = (v & 15) * 8;
                *(LAS v4u*)(Qc + r * 128 + c8) = *(const GAS v4u*)(QR + (tok0 + r) * 512 + h * 128 + c8);
                *(LAS v4u*)(Kc + r * 128 + c8) = *(const GAS v4u*)(KR + (tok0 + r) * 512 + h * 128 + c8); }
            { const int r = tid >> 2, c8 = (tid & 3) * 8; *(LAS v4u*)(Vc + r * 32 + c8) = *(const GAS v4u*)(VR + (tok0 + r) * 1024 + h * 256 + sl * 32 + c8); }
            __syncthreads();
            {
              const int n = tid >> 2, mq = tid & 3; float s[32];
#pragma unroll
              for (int mm = 0; mm < 32; ++mm) s[mm] = 0.f;
              for (int d0 = 0; d0 < 128; d0 += 8) {
                  const v4u qw = *(const LAS v4u*)(Qc + n * 128 + d0);
                  const float q0 = bflo(qw.x), q1 = bfhi(qw.x), q2 = bflo(qw.y), q3 = bfhi(qw.y), q4 = bflo(qw.z), q5 = bfhi(qw.z), q6 = bflo(qw.w), q7 = bfhi(qw.w);
#pragma unroll
                  for (int mm = 0; mm < 32; ++mm) { const v4u kw = *(const LAS v4u*)(Kc + (mq * 32 + mm) * 128 + d0);
                      s[mm] += (q0 * bflo(kw.x) + q1 * bfhi(kw.x)) + (q2 * bflo(kw.y) + q3 * bfhi(kw.y)) + (q4 * bflo(kw.z) + q5 * bfhi(kw.z)) + (q6 * bflo(kw.w) + q7 * bfhi(kw.w)); }
              }
#pragma unroll
              for (int mm = 0; mm < 32; ++mm) { const int m = mq * 32 + mm; Sc[n * 128 + m] = m <= n ? s[mm] * exp2f(lg2 * (float)(n - m)) : 0.f; }
            }
            __syncthreads();
            {
              const int n = tid >> 2, e0 = (tid & 3) * 8; float in_[8], cr[8];
#pragma unroll
              for (int e = 0; e < 8; ++e) { in_[e] = 0.f; cr[e] = 0.f; }
              for (int m = 0; m < 128; ++m) { const float sv = Sc[n * 128 + m]; const v4u vw = *(const LAS v4u*)(Vc + m * 32 + e0);
                  in_[0] += sv * bflo(vw.x); in_[1] += sv * bfhi(vw.x); in_[2] += sv * bflo(vw.y); in_[3] += sv * bfhi(vw.y); in_[4] += sv * bflo(vw.z); in_[5] += sv * bfhi(vw.z); in_[6] += sv * bflo(vw.w); in_[7] += sv * bfhi(vw.w); }
              for (int d = 0; d < 128; ++d) { const float qv = bf2f(Qc[n * 128 + d]); const LAS float* sp = St + d * 32 + e0;
#pragma unroll
                  for (int e = 0; e < 8; ++e) cr[e] += qv * sp[e]; }
              const float xi = exp2f(lg2 * (float)(n + 1));
              v4u w; w.x = pk2(in_[0] + xi * cr[0], in_[1] + xi * cr[1]); w.y = pk2(in_[2] + xi * cr[2], in_[3] + xi * cr[3]); w.z = pk2(in_[4] + xi * cr[4], in_[5] + xi * cr[5]); w.w = pk2(in_[6] + xi * cr[6], in_[7] + xi * cr[7]);
              *(GAS v4u*)(ORAW + (tok0 + n) * 1024 + h * 256 + sl * 32 + e0) = w;
            }
            __syncthreads();
            {
              const int d = tid >> 2, e0 = (tid & 3) * 8; float a[8];
#pragma unroll
              for (int e = 0; e < 8; ++e) a[e] = 0.f;
              for (int m = 0; m < 128; ++m) { const float kv = bf2f(Kc[m * 128 + d]) * exp2f(lg2 * (float)(127 - m)); const v4u vw = *(const LAS v4u*)(Vc + m * 32 + e0);
                  a[0] += kv * bflo(vw.x); a[1] += kv * bfhi(vw.x); a[2] += kv * bflo(vw.y); a[3] += kv * bfhi(vw.y); a[4] += kv * bflo(vw.z); a[5] += kv * bfhi(vw.z); a[6] += kv * bflo(vw.w); a[7] += kv * bfhi(vw.w); }
              LAS float* sp = St + d * 32 + e0;
#pragma unroll
              for (int e = 0; e < 8; ++e) sp[e] = gamma_c * sp[e] + a[e];
            }
        }
    }
    __syncthreads();
}
__device__ __forceinline__ void ret_post_phase(Frame& F, const Args& A) {
    const bf16* ORAW = (const bf16*)(F.ws + WS_ORAW); const bf16* GS = (const bf16*)(F.ws + WS_GS); bf16* ORR = (bf16*)(F.ws + WS_ORR); const float* gnw = (const float*)A.in[12];
    const int gw = blockIdx.x * NWAVES + F.wave, NGW = F.G * NWAVES;
    for (int it = gw; it < M * 4; it += NGW) {
        const size_t off = (size_t)it * 256 + F.lane * 4;
        const unsigned long long w = *(const GAS unsigned long long*)(ORAW + off);
        const float v0 = bflo((unsigned)w), v1 = bfhi((unsigned)w), v2 = bflo((unsigned)(w >> 32)), v3 = bfhi((unsigned)(w >> 32));
        const float mu = wave_sum((v0 + v1) + (v2 + v3)) * (1.0f / 256.0f);
        const float d0 = v0 - mu, d1 = v1 - mu, d2 = v2 - mu, d3 = v3 - mu;
        const float var = wave_sum((d0 * d0 + d1 * d1) + (d2 * d2 + d3 * d3)) * (1.0f / 256.0f);
        const float rs = 1.0f / sqrtf(var + 1e-5f);
        const unsigned long long g = *(const GAS unsigned long long*)(GS + off);
        const f32x4 gw4 = *(const GAS f32x4*)(gnw + (it & 3) * 256 + F.lane * 4);
        const unsigned lo = pk2(d0 * rs * gw4.x * bflo((unsigned)g), d1 * rs * gw4.y * bfhi((unsigned)g)), hi = pk2(d2 * rs * gw4.z * bflo((unsigned)(g >> 32)), d3 * rs * gw4.w * bfhi((unsigned)(g >> 32)));
        *(GAS unsigned long long*)(ORR + off) = (unsigned long long)lo | ((unsigned long long)hi << 32);
    }
}

__global__ void __launch_bounds__(NWAVES * 64, 2) hybrid_fwd(Args args) {
    extern __shared__ __attribute__((aligned(16))) unsigned char lds[];
    Frame F;
    F.lds = (LAS unsigned char*)lds; F.MISC = (volatile LAS unsigned*)(F.lds + MISC_OFF);
    F.tid = threadIdx.x; F.lane = F.tid & 63; F.wave = __builtin_amdgcn_readfirstlane(F.tid >> 6); F.G = gridDim.x;
    F.ws = args.ws; F.ctl = (gu32*)(args.ws + WS_CTL);
    for (int u = F.tid; u < (LDS_BYTES - MISC_OFF) / 4; u += NWAVES * 64) ((LAS unsigned*)(F.lds + MISC_OFF))[u] = 0u;
    __syncthreads();
    XcdBarrier bar; bar.bar = (unsigned*)(F.ctl + CW_BAR) + args.li * XCD_BAR_WORDS; bar.x = 0; bar.st = nullptr;
    if (MK_N_LAUNCHES != N_PHASES) bar = xcd_barrier_post((unsigned*)(F.ctl + CW_BAR) + args.li * XCD_BAR_WORDS, F.MISC + 8);
    const int lo = args.ph_lo, hi = args.ph_hi;
#define IN(k) (lo <= (k) && (k) < hi)
#define SEAM(k) do { if (IN(k) && IN((k) + 1)) xcd_barrier(bar); } while (0)
    unsigned char* ws = args.ws;
    if (IN(0)) { p0_prologue(F, args); SEAM(0); }
    if (IN(1)) {
        pg8::Gemm g{(const bf16_t*)(ws + WS_XN), (const bf16_t*)(ws + WS_WIN), M, INW, DM}; pg8::StaticOrder S; S.init(M, INW, F.G, (int)blockIdx.x);
        EpiProj E{(bf16_t*)(ws + WS_QD), (bf16_t*)(ws + WS_KD), (bf16_t*)(ws + WS_QR), (bf16_t*)(ws + WS_KR), (bf16_t*)args.out, ws,
                  (const float*)(ws + WS_CS), (const float*)args.in[4], (const float*)args.in[5]};
        pg8::gemm_phase<EpiProj, pg8::StaticOrder, true, true>(F.lds, g, S, E);
        SEAM(1);
    }
    if (IN(2)) { attn_naive_phase(F, args); ret_naive_phase(F); SEAM(2); }
    if (IN(3)) { ret_post_phase(F, args); SEAM(3); }
    if (IN(4)) {
        { pg8::Gemm g{(const bf16_t*)(ws + WS_OA), (const bf16_t*)(ws + WS_WA), M, DM, 512}; pg8::StaticOrder S; S.init(M, DM, F.G, (int)blockIdx.x);
          EpiMerge<0> E{(const bf16_t*)args.out, (bf16_t*)(ws + WS_TMP), (bf16_t*)(ws + WS_MRG)};
          pg8::gemm_phase<EpiMerge<0>, pg8::StaticOrder, true, true>(F.lds, g, S, E); }
        { pg8::Gemm g{(const bf16_t*)(ws + WS_ORR), (const bf16_t*)(ws + WS_WR), M, DM, DM}; pg8::StaticOrder S; S.init(M, DM, F.G, (int)blockIdx.x);
          EpiMerge<1> E{(const bf16_t*)args.out, (bf16_t*)(ws + WS_TMP), (bf16_t*)(ws + WS_MRG)};
          pg8::gemm_phase<EpiMerge<1>, pg8::StaticOrder, true, true>(F.lds, g, S, E); }
        SEAM(4);
    }
    if (IN(5)) {
        pg8::Gemm g{(const bf16_t*)(ws + WS_MRG), (const bf16_t*)(ws + WS_WO), M, DM, DM}; pg8::StaticOrder S; S.init(M, DM, F.G, (int)blockIdx.x);
        EpiX1 E{(const float*)args.in[0], args.out, (bf16_t*)(ws + WS_XN), (float*)(ws + WS_RSS)};
        pg8::gemm_phase<EpiX1, pg8::StaticOrder, true, true>(F.lds, g, S, E);
        SEAM(5);
    }
    if (IN(6)) {
        pg8::Gemm g{(const bf16_t*)(ws + WS_XN), (const bf16_t*)(ws + WS_W1), M, FF, DM}; pg8::StaticOrder S; S.init(M, FF, F.G, (int)blockIdx.x);
        EpiHid E{(const float*)(ws + WS_RSS), (bf16_t*)(ws + WS_HID)};
        pg8::gemm_phase<EpiHid, pg8::StaticOrder, true, true>(F.lds, g, S, E);
        SEAM(6);
    }
    if (IN(7)) {
        pg8::Gemm g{(const bf16_t*)(ws + WS_HID), (const bf16_t*)(ws + WS_W2), M, DM, FF}; pg8::StaticOrder S; S.init(M, DM, F.G, (int)blockIdx.x);
        EpiOut E{args.out};
        pg8::gemm_phase<EpiOut, pg8::StaticOrder, true, true>(F.lds, g, S, E);
    }
#undef IN
#undef SEAM
}

extern "C" void kernel_launch(void* const* d_in, const int* in_sizes, int n_in, void* d_out, int out_size, void* d_ws, size_t ws_size, hipStream_t stream) {
    static int grid = 0;
    if (grid == 0) {
        if (n_in != 18 || in_sizes[0] != M * DM || out_size != M * DM || ws_size < WS_END) { fprintf(stderr, "kernel_launch: unexpected shapes (n_in %d, in0 %d, out %d, ws %zu)\n", n_in, n_in > 0 ? in_sizes[0] : -1, out_size, ws_size); grid = -1; return; }
        int dev = 0, cus = 0;
        if (hipGetDevice(&dev) != hipSuccess || hipDeviceGetAttribute(&cus, hipDeviceAttributeMultiprocessorCount, dev) != hipSuccess) { grid = -1; return; }
        if (hipFuncSetAttribute((const void*)hybrid_fwd, hipFuncAttributeMaxDynamicSharedMemorySize, LDS_BYTES) != hipSuccess) { fprintf(stderr, "kernel_launch: hipFuncSetAttribute failed\n"); grid = -1; return; }
        int per_cu = 0;
        if (hipOccupancyMaxActiveBlocksPerMultiprocessor(&per_cu, (const void*)hybrid_fwd, NWAVES * 64, LDS_BYTES) != hipSuccess || per_cu < 1) fprintf(stderr, "kernel_launch: occupancy query says %d\n", per_cu);
        (void)hipGetLastError();
        grid = cus;
    }
    if (grid < 0) return;
    hipMemsetAsync((char*)d_ws + WS_CTL, 0, CTL_ZERO_BYTES, stream);
    Args a{};
    for (int i = 0; i < 18; ++i) a.in[i] = d_in[i];
    a.out = (float*)d_out; a.ws = (unsigned char*)d_ws;
    for (int j = 0; j < 8; ++j) a.invf[j] = std::pow(500000.0, -(double)(2 * j) / 16.0);
    for (int j = 0; j < 64; ++j) a.invf[8 + j] = 1.0 / std::pow(10000.0, (double)j / 63.0);
    const int nl = MK_N_LAUNCHES;
    for (int li = 0; li < nl; ++li) {
        if (nl == N_PHASES) { a.ph_lo = li; a.ph_hi = li + 1; a.li = 0; }
        else { a.ph_lo = li * N_PHASES / nl; a.ph_hi = (li + 1) * N_PHASES / nl; a.li = li; }
        hipLaunchKernelGGL(hybrid_fwd, dim3(grid), dim3(NWAVES * 64), LDS_BYTES, stream, a);
    }
}
```

```cpp
#include <hip/hip_runtime.h>
#include <cstdio>
#include <cstdint>
#include <cmath>
namespace pg8 {
#define PG8_LAS __attribute__((address_space(3)))
typedef unsigned short bf16_t;
typedef short bf16x8 __attribute__((ext_vector_type(8)));
typedef float f32x4 __attribute__((ext_vector_type(4)));
typedef unsigned u32x4 __attribute__((ext_vector_type(4)));
constexpr int BM = 256, BK = 64, HALF = 128, HTB = HALF * BK * 2  , STAGE_BYTES = 8 * HTB, NXCD = 8, WGM = 8;

__host__ __device__ __forceinline__ int lds_byte(int r, int c) { const int st = (r >> 4) * 2 + (c >> 5), rr = r & 15, cc = c & 31, ob = rr * 64 + cc * 2; return st * 1024 + (ob ^ (((ob >> 9) & 1) << 5)); }
__host__ __device__ __forceinline__ void stage_rc(int b, int& R, int& C) { const int st = b / 1024, sb = b % 1024, swz = sb ^ (((sb >> 9) & 1) << 5); R = (st >> 1) * 16 + swz / 64; C = (st & 1) * 32 + (swz % 64) / 2; }
__host__ __device__ __forceinline__ int perm32(int rho) { const int n = rho >> 4, i = rho & 15; return 8 * (i >> 2) + 4 * n + (i & 3); }

struct Unit { int pm, pn; };
struct Gemm { const bf16_t* A; const bf16_t* Bt; int M, N, K; };

struct StaticOrder {
    int nM, nN, nwg, G, c;
    __host__ __device__ void init(int M, int N, int G_, int c_) { nM = M / BM; nN = N / BM; nwg = nM * nN; G = G_; c = c_; }
    __host__ __device__ bool next(int i, Unit& u) const {
        const long L = (long)i * G + c; if (L >= nwg) return false;
        int wgid = (int)L; { const int q = nwg / NXCD, r = nwg % NXCD, xcd = wgid % NXCD, off = wgid / NXCD; wgid = (xcd < r ? xcd * (q + 1) : r * (q + 1) + (xcd - r) * q) + off; }
        const int nig = WGM * nN, gid = wgid / nig, fm = gid * WGM, gsz = (nM - fm) < WGM ? (nM - fm) : WGM;
        u.pm = fm + ((wgid % nig) % gsz); u.pn = (wgid % nig) / gsz; return true;
    }
    __device__ __forceinline__ void a_ready(const Unit&) const {}
    __device__ __forceinline__ void done(const Unit&) const {}
};

__device__ __forceinline__ unsigned cvt_pk_bf16(float lo, float hi) { unsigned r; asm volatile("v_cvt_pk_bf16_f32 %0, %1, %2" : "=v"(r) : "v"(lo), "v"(hi)); return r; }
typedef float f32x2 __attribute__((ext_vector_type(2)));
#define PROBE_TK 0
#define PROBE_TAG 1
#define PROBE_TW 0
#define PROBE_TS 1
template <class Epi, class Sched, bool ALIGN_EPI = false, bool SP2 = false>
__device__ __forceinline__ void gemm_phase(PG8_LAS unsigned char* lds, const Gemm g, const Sched& S, const Epi& E) {
    int tid_ = threadIdx.x; asm volatile("" : "+v"(tid_));
    const int tid = tid_, wid = __builtin_amdgcn_readfirstlane(tid >> 6), lane = tid & 63, wr = wid >> 2, wc = wid & 3, fr = lane & 15, fq = lane >> 4;
    const int K = g.K, nt = K / BK;
    unsigned voffA[2], voffB[2];
#pragma unroll
    for (int i = 0; i < 2; ++i) { int R, C; stage_rc(tid * 16 + i * 8192, R, C); const int Rb = Epi::PERM ? ((R & ~31) + perm32(R & 31)) : R;
        voffA[i] = (unsigned)(R * K + C) * 2u; voffB[i] = (unsigned)(Rb * K + C) * 2u; }
    const size_t kstep = (size_t)(BK * 2);
    const size_t hstep = (size_t)HALF * K * 2;
    const size_t tstep = 2 * hstep;
    const unsigned ldsw = (unsigned)wid * 1024u; const unsigned lds0_ = (unsigned)__builtin_amdgcn_readfirstlane((int)((unsigned)(size_t)lds + (unsigned)wid * 1024u));
    const int aoff = lds_byte(wr * 64 + fr, fq * 8), boff = lds_byte(wc * 32 + fr, fq * 8);
#define PG8_SA(b, h) (((b) * 2 + (h)) * HTB)
#define PG8_SB(b, h) ((4 + (b) * 2 + (h)) * HTB)
#define PG8_STAGE(bufoff, gbase, voff) do { unsigned keep_; const unsigned d0_ = lds0_ + (unsigned)(bufoff), d1_ = d0_ + 8192u; \
        asm volatile("s_mov_b32 %0, m0\n\ts_mov_b32 m0, %3\n\ts_nop 0\n\tglobal_load_lds_dwordx4 %1, %5\n\ts_mov_b32 m0, %4\n\ts_nop 0\n\tglobal_load_lds_dwordx4 %2, %5\n\ts_mov_b32 m0, %0" \
                     : "=&s"(keep_) : "v"((voff)[0]), "v"((voff)[1]), "s"(d0_), "s"(d1_), "s"((const char*)(gbase)) : "memory"); } while (0)
#define PG8_LDA(dst, b, h) do { _Pragma("unroll") for (int m = 0; m < 4; ++m) _Pragma("unroll") for (int k = 0; k < 2; ++k) dst[m][k] = *(const PG8_LAS bf16x8*)(lds + PG8_SA(b, h) + aoff + m * 2048 + k * 1024); } while (0)
#define PG8_LDB(dst, b, h) do { _Pragma("unroll") for (int n = 0; n < 2; ++n) _Pragma("unroll") for (int k = 0; k < 2; ++k) dst[n][k] = *(const PG8_LAS bf16x8*)(lds + PG8_SB(b, h) + boff + n * 2048 + k * 1024); } while (0)
#define PG8_MMA(ai, bj, At, Bt) do { if (!SP2) __builtin_amdgcn_s_setprio(1); _Pragma("unroll") for (int m = 0; m < 4; ++m) _Pragma("unroll") for (int n = 0; n < 2; ++n) _Pragma("unroll") for (int k = 0; k < 2; ++k) \
        acc[ai][bj][m][n] = __builtin_amdgcn_mfma_f32_16x16x32_bf16(Bt[n][k], At[m][k], acc[ai][bj][m][n], 0, 0, 0); if (!SP2) __builtin_amdgcn_s_setprio(0); } while (0)
#define PG8_WAIT_V(n) asm volatile("s_waitcnt vmcnt(" #n ")" ::: "memory")
#define PG8_WAIT_L(n) __builtin_amdgcn_s_waitcnt(0xC07F | ((n) << 8))
#define PG8_BAR __builtin_amdgcn_s_barrier()
#define PG8_SCHED __builtin_amdgcn_sched_barrier(0)
    unsigned long long tprev_ = 0, tloc_ = 0;
#define PG8_T0(k) do { if (PROBE_TK == (k) && Epi::TAG == PROBE_TAG && wid == PROBE_TW) { PG8_SCHED; tprev_ = __builtin_amdgcn_s_memrealtime(); PG8_SCHED; } } while (0)
#define PG8_T1(k) do { if (PROBE_TK == (k) && Epi::TAG == PROBE_TAG && wid == PROBE_TW) { PG8_SCHED; tloc_ += __builtin_amdgcn_s_memrealtime() - tprev_; PG8_SCHED; } } while (0)
    Unit cur, nxt; int ui = 0;
    if (!S.next(0, cur)) return;
    f32x4 acc[2][2][4][2];
#pragma unroll
    for (int a = 0; a < 2; ++a)
#pragma unroll
        for (int b = 0; b < 2; ++b)
#pragma unroll
            for (int m = 0; m < 4; ++m)
#pragma unroll
                for (int n = 0; n < 2; ++n) acc[a][b][m][n] = (f32x4){0.f, 0.f, 0.f, 0.f};
    bf16x8 At[4][2], B0[2][2], B1[2][2];
    const char* cA = (const char*)g.A + (size_t)cur.pm * tstep; const char* cB = (const char*)g.Bt + (size_t)cur.pn * tstep;
    S.a_ready(cur);
    if constexpr (SP2) {
        PG8_STAGE(PG8_SB(0, 0), cB, voffB); PG8_STAGE(PG8_SB(0, 1), cB + hstep, voffB); PG8_STAGE(PG8_SA(0, 0), cA, voffA); PG8_STAGE(PG8_SA(0, 1), cA + hstep, voffA);
        if (wr == 1) PG8_BAR;
        PG8_WAIT_V(2); PG8_BAR;
        PG8_STAGE(PG8_SB(1, 0), cB + kstep, voffB); PG8_STAGE(PG8_SA(1, 0), cA + kstep, voffA); PG8_STAGE(PG8_SB(1, 1), cB + hstep + kstep, voffB);
        PG8_WAIT_V(6); PG8_BAR;
    } else {
        PG8_STAGE(PG8_SB(0, 0), cB, voffB); PG8_STAGE(PG8_SA(0, 0), cA, voffA); PG8_STAGE(PG8_SB(0, 1), cB + hstep, voffB); PG8_STAGE(PG8_SA(0, 1), cA + hstep, voffA);
        if (wr == 1) PG8_BAR;
        PG8_WAIT_V(4); PG8_BAR;
        PG8_STAGE(PG8_SB(1, 0), cB + kstep, voffB); PG8_STAGE(PG8_SA(1, 0), cA + kstep, voffA); PG8_STAGE(PG8_SB(1, 1), cB + hstep + kstep, voffB);
        PG8_WAIT_V(6); PG8_BAR;
    }
    for (;;) {
        const bool has_next = S.next(ui + 1, nxt);
        const char* nA = has_next ? (const char*)g.A + (size_t)nxt.pm * tstep : cA; const char* nB = has_next ? (const char*)g.Bt + (size_t)nxt.pn * tstep : cB;
        for (int t = 0; t < nt; t += 2) {
            if constexpr (Epi::MIDK > 0) { if (t == Epi::MIDK) E.mid(acc, cur, wr, wc, fr, fq); }
            const bool last = (t == nt - 2);
            const char* a1 = cA + (size_t)(t + 1) * kstep;
            const char* a2 = last ? nA : cA + (size_t)(t + 2) * kstep; const char* b2 = last ? nB : cB + (size_t)(t + 2) * kstep;
            const char* a3 = a2 + kstep; const char* b3 = b2 + kstep;
            if (last && has_next) S.a_ready(nxt);
            if constexpr (SP2) {
            PG8_LDB(B0, 0, 0); PG8_LDB(B1, 0, 1); PG8_SCHED; PG8_LDA(At, 0, 0); PG8_STAGE(PG8_SA(1, 1), a1 + hstep, voffA);
            PG8_WAIT_V(8); PG8_WAIT_L(0); PG8_BAR; __builtin_amdgcn_s_setprio(1); PG8_MMA(0, 0, At, B0); PG8_MMA(0, 1, At, B1); __builtin_amdgcn_s_setprio(0); PG8_BAR; PG8_SCHED;
            PG8_LDA(At, 0, 1); PG8_STAGE(PG8_SB(0, 0), b2, voffB); PG8_STAGE(PG8_SB(0, 1), b2 + hstep, voffB); PG8_STAGE(PG8_SA(0, 0), a2, voffA);
            PG8_WAIT_V(8); PG8_WAIT_L(0); PG8_BAR; __builtin_amdgcn_s_setprio(1); PG8_MMA(1, 0, At, B0); PG8_MMA(1, 1, At, B1); __builtin_amdgcn_s_setprio(0); PG8_BAR; PG8_SCHED;
            PG8_LDB(B0, 1, 0); PG8_LDB(B1, 1, 1); PG8_SCHED; PG8_LDA(At, 1, 0); PG8_STAGE(PG8_SA(0, 1), a2 + hstep, voffA);
            PG8_WAIT_V(8); PG8_WAIT_L(0); PG8_BAR; __builtin_amdgcn_s_setprio(1); PG8_MMA(0, 0, At, B0); PG8_MMA(0, 1, At, B1); __builtin_amdgcn_s_setprio(0); PG8_BAR; PG8_SCHED;
            PG8_LDA(At, 1, 1); PG8_STAGE(PG8_SB(1, 0), b3, voffB); PG8_STAGE(PG8_SB(1, 1), b3 + hstep, voffB); PG8_STAGE(PG8_SA(1, 0), a3, voffA);
            PG8_WAIT_V(8); PG8_WAIT_L(0); PG8_BAR; __builtin_amdgcn_s_setprio(1); PG8_MMA(1, 0, At, B0); PG8_MMA(1, 1, At, B1); __builtin_amdgcn_s_setprio(0); PG8_BAR; PG8_SCHED;
            } else {
            PG8_LDB(B0, 0, 0); PG8_SCHED; PG8_LDA(At, 0, 0); PG8_STAGE(PG8_SA(1, 1), a1 + hstep, voffA);
            PG8_WAIT_L(8); PG8_BAR; PG8_WAIT_L(0); PG8_MMA(0, 0, At, B0); PG8_BAR; PG8_SCHED;
            PG8_LDB(B1, 0, 1); PG8_STAGE(PG8_SB(0, 0), b2, voffB);
            PG8_BAR; PG8_WAIT_L(0); PG8_MMA(0, 1, At, B1); PG8_BAR;
            PG8_LDA(At, 0, 1); PG8_STAGE(PG8_SA(0, 0), a2, voffA);
            PG8_BAR; PG8_WAIT_L(0); PG8_MMA(1, 0, At, B0); PG8_BAR; PG8_SCHED;
            PG8_STAGE(PG8_SB(0, 1), b2 + hstep, voffB);
            PG8_WAIT_V(6); PG8_BAR; PG8_MMA(1, 1, At, B1); PG8_BAR;
            PG8_LDB(B0, 1, 0); PG8_SCHED; PG8_LDA(At, 1, 0); PG8_STAGE(PG8_SA(0, 1), a2 + hstep, voffA);
            PG8_WAIT_L(8); PG8_BAR; PG8_WAIT_L(0); PG8_MMA(0, 0, At, B0); PG8_BAR; PG8_SCHED;
            PG8_LDB(B1, 1, 1); PG8_STAGE(PG8_SB(1, 0), b3, voffB);
            PG8_BAR; PG8_WAIT_L(0); PG8_MMA(0, 1, At, B1); PG8_BAR;
            PG8_LDA(At, 1, 1); PG8_STAGE(PG8_SA(1, 0), a3, voffA);
            PG8_BAR; PG8_WAIT_L(0); PG8_MMA(1, 0, At, B0); PG8_BAR; PG8_SCHED;
            PG8_STAGE(PG8_SB(1, 1), b3 + hstep, voffB);
            PG8_WAIT_V(6); PG8_BAR; PG8_MMA(1, 1, At, B1); PG8_BAR;
            }
        }
        if constexpr (ALIGN_EPI) { if (wr == 0) PG8_BAR; }
        PG8_T0(11);
        if constexpr (!Epi::AFTER_DRAIN) { E(acc, cur, wr, wc, fr, fq); S.done(cur); }
        PG8_T1(11);
        if (!has_next) break;
#pragma unroll
        for (int a = 0; a < 2; ++a)
#pragma unroll
            for (int b = 0; b < 2; ++b)
#pragma unroll
                for (int m = 0; m < 4; ++m)
#pragma unroll
                    for (int n = 0; n < 2; ++n) acc[a][b][m][n] = (f32x4){0.f, 0.f, 0.f, 0.f};
        cur = nxt; cA = nA; cB = nB; ++ui;
        if constexpr (ALIGN_EPI) { if (wr == 1) PG8_BAR; }
    }
    if (PROBE_TK >= 5 && PROBE_TK < 20 && Epi::TAG == PROBE_TAG && wid == PROBE_TW && lane == 0) { PG8_LAS unsigned* tw = (PG8_LAS unsigned*)(lds + 163840 - 128); *tw += (unsigned)tloc_; }
    PG8_WAIT_V(0);
    if constexpr (!ALIGN_EPI) { if (wr == 0) PG8_BAR; }
    PG8_BAR;
    if constexpr (Epi::AFTER_DRAIN) { E.fused(acc, cur, wr, wc, fr, fq, lds, wid, lane); S.done(cur); }
#undef PG8_SA
#undef PG8_SB
#undef PG8_STAGE
#undef PG8_LDA
#undef PG8_LDB
#undef PG8_MMA
#undef PG8_WAIT_V
#undef PG8_WAIT_L
#undef PG8_BAR
#undef PG8_SCHED
#undef PG8_T0
#undef PG8_T1
}
}
#define GAS __attribute__((address_space(1)))
#define LAS __attribute__((address_space(3)))
typedef unsigned short bf16;
typedef unsigned v4u __attribute__((ext_vector_type(4)));
typedef float f32x4 __attribute__((ext_vector_type(4)));
typedef short bf16x8 __attribute__((ext_vector_type(8)));
typedef GAS unsigned gu32;
typedef GAS unsigned long long gu64;
#define RLX_AGENT __ATOMIC_RELAXED, __HIP_MEMORY_SCOPE_AGENT
#define LDS_WAIT() asm volatile("s_waitcnt lgkmcnt(0)" ::: "memory")
#define VM_WAIT() asm volatile("s_waitcnt vmcnt(0)" ::: "memory")
__device__ __forceinline__ unsigned long long rt() { return __builtin_amdgcn_s_memrealtime(); }
__device__ __forceinline__ unsigned f2bf(float f) { unsigned u = __builtin_bit_cast(unsigned, f); return (u + 0x7fffu + ((u >> 16) & 1u)) >> 16; }
__device__ __forceinline__ unsigned pk2(float lo, float hi) { return f2bf(lo) | (f2bf(hi) << 16); }

#define XB_TMO      128
#define XB_XCNT(j)  (256  + 64 * (j))
#define XB_XSUB(j)  (1280 + 64 * (j))
#define XB_XGEN(j)  (2304 + 64 * (j))
#define XB_TOP      3328
#define XB_TOPGEN   3392
#define XCD_BAR_WORDS 3456
#define XB_SPIN_CAP (1u << 18)

__device__ __forceinline__ unsigned xb_ld(unsigned* p)              { return __hip_atomic_load(p, __ATOMIC_RELAXED, __HIP_MEMORY_SCOPE_AGENT); }
__device__ __forceinline__ unsigned xb_add(unsigned* p, unsigned v) { return __hip_atomic_fetch_add(p, v, __ATOMIC_RELAXED, __HIP_MEMORY_SCOPE_AGENT); }
__device__ __forceinline__ unsigned xb_xcc_id() { return (unsigned)__builtin_amdgcn_s_getreg((3 << 11) | 20) & 0xFu; }
#define XB_SPIN(cond, bar) do { unsigned _sp = 0; while (cond) { __builtin_amdgcn_s_sleep(1); \
    if ((++_sp & 255u) == 0u) { if (xb_ld(&(bar)[XB_TMO])) break; if (_sp > XB_SPIN_CAP) { atomicAdd(&(bar)[XB_TMO], 1u); break; } } } } while (0)

struct XcdBarrier {
    unsigned* bar; unsigned x;
    volatile LAS unsigned* st;
};

__device__ __forceinline__ XcdBarrier xcd_barrier_post(unsigned* bar, volatile LAS unsigned* st) {
    XcdBarrier b; b.bar = bar; b.x = xb_xcc_id(); b.st = st;
    if (threadIdx.x == 0) (void)xb_add(&bar[XB_XCNT(b.x)], 1u);
    return b;
}
__device__ __forceinline__ void xcd_barrier_complete(unsigned* bar, unsigned x, unsigned& nloc, unsigned& nx) {
    const unsigned G = gridDim.x * gridDim.y * gridDim.z;
    unsigned sum, cnt, mine, sp = 0u;
    for (;;) {
        sum = 0u; cnt = 0u; mine = 0u;
#pragma unroll
        for (unsigned j = 0; j < 16; ++j) { const unsigned c = xb_ld(&bar[XB_XCNT(j)]); sum += c; cnt += (c > 0u) ? 1u : 0u; mine = (j == x) ? c : mine; }
        if (sum == G) break;
        __builtin_amdgcn_s_sleep(1);
        if ((++sp & 255u) == 0u) { if (xb_ld(&bar[XB_TMO])) break; if (sp > XB_SPIN_CAP) { atomicAdd(&bar[XB_TMO], 1u); break; } }
    }
    nloc = mine > 0u ? mine : 1u; nx = cnt > 0u ? cnt : 1u;
}

__device__ __forceinline__ void xcd_barrier(const XcdBarrier& b) {
    asm volatile("s_waitcnt vmcnt(0)" ::: "memory");
    __syncthreads();
    if (threadIdx.x == 0) {
        unsigned* bar = b.bar;
        __builtin_amdgcn_s_waitcnt(0);
        unsigned nloc = b.st[0], nx = b.st[1];
        if (nloc == 0u) { xcd_barrier_complete(bar, b.x, nloc, nx); b.st[0] = nloc; b.st[1] = nx; }
        const unsigned old = xb_add(&bar[XB_XSUB(b.x)], 1u);
        const unsigned gen = old / nloc;
        if (old + 1u == (gen + 1u) * nloc) {
            __builtin_amdgcn_fence(__ATOMIC_RELEASE, "agent");
            asm volatile("s_waitcnt vmcnt(0)" ::: "memory");
            const unsigned og = xb_add(&bar[XB_TOP], 1u);
            const unsigned tg = og / nx;
            if (og + 1u == (tg + 1u) * nx) xb_add(&bar[XB_TOPGEN], 1u);
            else XB_SPIN(xb_ld(&bar[XB_TOPGEN]) == tg, bar);
            __builtin_amdgcn_fence(__ATOMIC_ACQUIRE, "agent");
            xb_add(&bar[XB_XGEN(b.x)], 1u);
            asm volatile("s_waitcnt vmcnt(0)" ::: "memory");
        } else {
            XB_SPIN(xb_ld(&bar[XB_XGEN(b.x)]) == gen, bar);
            __builtin_amdgcn_fence(__ATOMIC_ACQUIRE, "agent");
            asm volatile("s_waitcnt vmcnt(0)" ::: "memory");
        }
    }
    __syncthreads();
}

constexpr int NWAVES = 8;
constexpr int BATCH = 8, SEQ = 4096, DM = 1024, M = BATCH * SEQ, INW = 6656, FF = 4096;
constexpr int NFREQ = 72;
constexpr float C2 = 0.125f * 1.4426950408889634f;
constexpr float KR_SCALE = 0.08838834764831845f;
constexpr float LAMBDA_INIT = 0.2f;
constexpr int N_PHASES = 8;
#define PROBE_CLK -1
#define PROBE_CLK_E -1
#define PROBE_CLK_DUR 0
#ifndef PROBE_XCC
#define PROBE_XCC 0
#endif
#ifndef PROBE_STAGGER
#define PROBE_STAGGER 0
#endif
#ifndef PROBE_ST2
#define PROBE_ST2 0
#endif
#ifndef MK_N_LAUNCHES
#define MK_N_LAUNCHES 1
#endif

constexpr size_t MiB = 1u << 20;
constexpr size_t WS_CTL = 0, CTL_ZERO_BYTES = 64 * 1024;
constexpr size_t WS_WIN = 2 * MiB, WS_WA = 15 * MiB, WS_WR = 16 * MiB, WS_WO = 18 * MiB, WS_W1 = 20 * MiB, WS_W2 = 28 * MiB;
constexpr size_t WS_CS = 36 * MiB;
constexpr size_t WS_RSS = 54 * MiB;
constexpr size_t WS_MISC = 56 * MiB;
constexpr size_t WS_XN = 64 * MiB;
constexpr size_t WS_QD = 128 * MiB, WS_KD = 160 * MiB, WS_VD = 192 * MiB, WS_QR = 224 * MiB, WS_KR = 256 * MiB;
constexpr size_t WS_VR = 288 * MiB, WS_GS = 352 * MiB;
constexpr size_t WS_OA = 416 * MiB;
constexpr size_t WS_ORR = 448 * MiB;
constexpr size_t WS_TMP = 128 * MiB, WS_MRG = 192 * MiB;
constexpr size_t WS_HID = 128 * MiB;
constexpr size_t WS_ORAW = WS_XN;
constexpr size_t WS_KV = WS_XN;
constexpr size_t WS_ST = WS_QD;
constexpr size_t WS_END = 512 * MiB;
constexpr int CW_BAR = 4096;

constexpr int RING_BYTES = 131072;
constexpr int LDS_BYTES = 163840;
constexpr int MISC_OFF = LDS_BYTES - 256;

struct Frame {
    LAS unsigned char* lds;
    volatile LAS unsigned* MISC;
    gu32* ctl;
    int tid, lane, wave, G;
    unsigned char* ws;
    unsigned long long tacc;
};
struct Args { const void* in[18]; float* out; unsigned char* ws; double invf[NFREQ]; float lg2[4]; int ph_lo, ph_hi, li, pad; };

__device__ __forceinline__ float wave_sum(float v) {
#pragma unroll
    for (int o = 1; o < 64; o <<= 1) v += __shfl_xor(v, o);
    return v;
}
__device__ __forceinline__ float bf2f(unsigned short h) { return __builtin_bit_cast(float, (unsigned)h << 16); }
__device__ __forceinline__ float bflo(unsigned w) { return __builtin_bit_cast(float, w << 16); }
__device__ __forceinline__ float bfhi(unsigned w) { return __builtin_bit_cast(float, w & 0xffff0000u); }

__host__ __device__ __forceinline__ int da_dim(int bj, int i, int fq) {
    if (bj == 0 && i < 4) return (i & 1) + 2 * fq + 8 * (i >> 1);
    const int idx = bj == 0 ? i - 4 : 4 + i; return 16 + 12 * fq + idx;
}
__host__ __device__ __forceinline__ int win_col(int p) {
    const int pn = p >> 8, t = p & 255, bj = t >> 7, wc = (t >> 5) & 3, fq = (t >> 3) & 3, i = t & 7;
    if (pn < 4) { const int G = 4 * (pn & 1) + wc; return (pn >> 1) * 512 + 64 * G + da_dim(bj, i, fq); }
    if (pn >= 6 && pn < 10) { const int head = 2 * (pn & 1) + (wc >> 1); return 1536 + ((pn - 6) >> 1) * 512 + 128 * head + 64 * bj + 32 * (wc & 1) + 8 * fq + i; }
    if (pn >= 18) return 4608 + bj * 1024 + 128 * (pn - 18) + (t & 127);
    return p;
}

template <bool PERMUTE>
__device__ __forceinline__ void p0_transpose_item(const float* W, int K, int N, bf16* WT, LAS float* scr, int item, int lane, const float* kscale, int ldk = 0, int koff = 0) {
    if (ldk == 0) ldk = K;
    const int nblk = N / 32, kb = item / nblk, nb = item % nblk, k0 = 64 * kb, n0 = 32 * nb;
    const int col = PERMUTE ? win_col(n0 + (lane & 31)) : n0 + (lane & 31);
    if constexpr (PERMUTE) {
        float v[32];
#pragma unroll
        for (int i = 0; i < 32; ++i) v[i] = __builtin_nontemporal_load((const GAS float*)W + (size_t)(k0 + 2 * i + (lane >> 5)) * N + col);
#pragma unroll
        for (int i = 0; i < 32; ++i) { const int kk = 2 * i + (lane >> 5); scr[kk * 33 + (lane & 31)] = kscale ? v[i] * kscale[k0 + kk] : v[i]; }
    } else {
        f32x4 v[8];
#pragma unroll
        for (int i = 0; i < 8; ++i) v[i] = __builtin_nontemporal_load((const GAS f32x4*)(W + (size_t)(k0 + 8 * i + (lane >> 3)) * N + n0 + 4 * (lane & 7)));
#pragma unroll
        for (int i = 0; i < 8; ++i) { const int kk = 8 * i + (lane >> 3); const float ks = kscale ? kscale[k0 + kk] : 1.0f; LAS float* d = scr + kk * 33 + 4 * (lane & 7);
            d[0] = v[i][0] * ks; d[1] = v[i][1] * ks; d[2] = v[i][2] * ks; d[3] = v[i][3] * ks; }
    }
    LDS_WAIT(); asm volatile("" ::: "memory");
    const int c = lane & 7;
#pragma unroll
    for (int j = 0; j < 4; ++j) { const int n = (lane >> 3) + 8 * j; const LAS float* s = scr + (8 * c) * 33 + n;
        v4u o; o.x = pk2(s[0 * 33], s[1 * 33]); o.y = pk2(s[2 * 33], s[3 * 33]); o.z = pk2(s[4 * 33], s[5 * 33]); o.w = pk2(s[6 * 33], s[7 * 33]);
        *(GAS v4u*)(WT + (size_t)(n0 + n) * ldk + koff + k0 + 8 * c) = o; }
    LDS_WAIT(); asm volatile("" ::: "memory");
}
__device__ __forceinline__ void p0_prologue(Frame& F, const Args& A, int parts = 3) {
    const float* x = (const float*)A.in[0]; const float* n1w = (const float*)A.in[2];
    LAS float* scr = (LAS float*)(F.lds + F.wave * 16384);
    const int gw = blockIdx.x * NWAVES + F.wave, NGW = F.G * NWAVES;
    constexpr int I_IN = (DM / 64) * (INW / 32), I_A = (512 / 64) * (DM / 32), I_R = (DM / 64) * (DM / 32), I_O = I_R, I_1 = (DM / 64) * (FF / 32), I_2 = (FF / 64) * (DM / 32);
    constexpr int NITEMS = I_IN + I_A + I_R + I_O + I_1 + I_2;
    if (parts & 1) for (int it = gw; it < NITEMS; it += NGW) {
        int r = it;
        if (r < I_IN) { p0_transpose_item<true>((const float*)A.in[3], DM, INW, (bf16*)(F.ws + WS_WIN), scr, r, F.lane, nullptr); continue; } r -= I_IN;
        if (r < I_A) { p0_transpose_item<false>((const float*)A.in[11], 512, DM, (bf16*)(F.ws + WS_WA), scr, r, F.lane, nullptr, 1536, 0); continue; } r -= I_A;
        if (r < I_R) { p0_transpose_item<false>((const float*)A.in[13], DM, DM, (bf16*)(F.ws + WS_WA), scr, r, F.lane, nullptr, 1536, 512); continue; } r -= I_R;
        if (r < I_O) { p0_transpose_item<false>((const float*)A.in[14], DM, DM, (bf16*)(F.ws + WS_WO), scr, r, F.lane, nullptr); continue; } r -= I_O;
        if (r < I_1) { p0_transpose_item<false>((const float*)A.in[16], DM, FF, (bf16*)(F.ws + WS_W1), scr, r, F.lane, (const float*)A.in[15]); continue; } r -= I_1;
        p0_transpose_item<false>((const float*)A.in[17], FF, DM, (bf16*)(F.ws + WS_W2), scr, r, F.lane, nullptr);
    }
    bf16* XN = (bf16*)(F.ws + WS_XN);
    f32x4 wv[4];
#pragma unroll
    for (int j = 0; j < 4; ++j) wv[j] = ((const GAS f32x4*)n1w)[128 * (j >> 1) + 2 * F.lane + (j & 1)];
    if (parts & 2) for (int m0 = gw; m0 < M; m0 += 4 * NGW) {
        f32x4 v[4][4];
#pragma unroll
        for (int r = 0; r < 4; ++r) { const int m = m0 + r * NGW < M ? m0 + r * NGW : m0; const GAS f32x4* xr = (const GAS f32x4*)(x + (size_t)m * DM) + 2 * F.lane;
#pragma unroll
            for (int j = 0; j < 2; ++j) { v[r][2 * j] = __builtin_nontemporal_load(xr + 128 * j); v[r][2 * j + 1] = __builtin_nontemporal_load(xr + 128 * j + 1); } }
#pragma unroll
        for (int r = 0; r < 4; ++r) { const int m = m0 + r * NGW; float s = 0.f;
#pragma unroll
            for (int j = 0; j < 4; ++j) s += (v[r][j].x * v[r][j].x + v[r][j].y * v[r][j].y) + (v[r][j].z * v[r][j].z + v[r][j].w * v[r][j].w);
            const float rstd = 1.f / sqrtf(wave_sum(s) * (1.f / DM) + 1e-6f);
            if (m < M) { GAS v4u* o16 = (GAS v4u*)(XN + (size_t)m * DM) + F.lane;
#pragma unroll
                for (int j = 0; j < 2; ++j) { const f32x4 a = v[r][2 * j], b = v[r][2 * j + 1], wa = wv[2 * j], wb = wv[2 * j + 1]; v4u o;
                    o.x = pk2(a.x * rstd * wa.x, a.y * rstd * wa.y); o.y = pk2(a.z * rstd * wa.z, a.w * rstd * wa.w); o.z = pk2(b.x * rstd * wb.x, b.y * rstd * wb.y); o.w = pk2(b.z * rstd * wb.z, b.w * rstd * wb.w);
                    o16[64 * j] = o; } } }
    }
    if (blockIdx.x == 0 && F.wave == 0) {
        const float* qn = (const float*)A.in[4]; const float* kn = (const float*)A.in[5];
        const float* l1q = (const float*)A.in[6]; const float* l1k = (const float*)A.in[7]; const float* l2q = (const float*)A.in[8]; const float* l2k = (const float*)A.in[9];
        const float s1 = wave_sum(l1q[F.lane] * l1k[F.lane]), s2 = wave_sum(l2q[F.lane] * l2k[F.lane]);
        float mq = fabsf(qn[F.lane]), mk = fabsf(kn[F.lane]);
#pragma unroll
        for (int o = 1; o < 64; o <<= 1) { mq = fmaxf(mq, __shfl_xor(mq, o)); mk = fmaxf(mk, __shfl_xor(mk, o)); }
        if (F.lane == 0) { GAS float* misc = (GAS float*)(F.ws + WS_MISC); misc[0] = expf(s1) - expf(s2) + LAMBDA_INIT; misc[1] = 8.0f * 1.4426950408889634f * mq * mk * 1.01f; }
    }
}

using pg8::bf16_t; using pg8::Unit; using pg8::cvt_pk_bf16;
typedef unsigned u32x4e __attribute__((ext_vector_type(4)));
__device__ __forceinline__ u32x4e pack8(const f32x4& a, const f32x4& b) { u32x4e w; w.x = cvt_pk_bf16(a[0], a[1]); w.y = cvt_pk_bf16(a[2], a[3]); w.z = cvt_pk_bf16(b[0], b[1]); w.w = cvt_pk_bf16(b[2], b[3]); return w; }
__device__ __forceinline__ float sigmoidf_(float v) { return __builtin_amdgcn_rcpf(1.0f + __builtin_amdgcn_exp2f(-1.4426950408889634f * v)); }

struct EpiProj {
    static constexpr bool PERM = true, AFTER_DRAIN = false; static constexpr int MIDK = 0; static constexpr int TAG = 1;
    bf16_t *QD, *KD, *QR, *KR, *GATE; unsigned char* ws; const int* pos; const float* qnw; const float* knw; float lg0, lg1, lg2, lg3;
    __device__ __forceinline__ void operator()(const f32x4 (&acc)[2][2][4][2], const Unit& u, int wr, int wc, int fr_, int fq_) const {
        int fr = fr_, fq = fq_; asm volatile("" : "+v"(fr), "+v"(fq));
        const int pn = u.pn, row0 = u.pm * 256 + wr * 64 + fr;
        if (pn < 4) {
            const bool isq = pn < 2; const float* nw = isq ? qnw : knw; bf16_t* dst = (isq ? QD : KD) + 64 * (4 * (pn & 1) + wc) + 8 * fq;
            const float osc = isq ? C2 : 1.0f;
            float w[2][8];
#pragma unroll
            for (int bj = 0; bj < 2; ++bj)
#pragma unroll
                for (int i = 0; i < 8; ++i) w[bj][i] = ((const GAS float*)nw)[da_dim(bj, i, fq)] * osc;
            const float rda0 = __builtin_amdgcn_exp2f(-(float)(2 * fq) * (18.931568569324174f / 8.0f)) * 0.15915494309189535f, rda1 = __builtin_amdgcn_exp2f(-(float)(2 * fq + 1) * (18.931568569324174f / 8.0f)) * 0.15915494309189535f;
            int pq[2][4];
#pragma unroll
            for (int ai = 0; ai < 2; ++ai)
#pragma unroll
                for (int m = 0; m < 4; ++m) pq[ai][m] = ((const GAS int*)pos)[row0 + ai * 128 + m * 16];
#pragma unroll
            for (int ai = 0; ai < 2; ++ai)
#pragma unroll
                for (int m = 0; m < 4; ++m) {
                    const int row = row0 + ai * 128 + m * 16;
                    f32x4 a0 = acc[ai][0][m][0], a1 = acc[ai][0][m][1], b0 = acc[ai][1][m][0], b1 = acc[ai][1][m][1];
                    float ss = (a0[0] * a0[0] + a0[1] * a0[1]) + (a0[2] * a0[2] + a0[3] * a0[3]) + (a1[0] * a1[0] + a1[1] * a1[1]) + (a1[2] * a1[2] + a1[3] * a1[3])
                             + (b0[0] * b0[0] + b0[1] * b0[1]) + (b0[2] * b0[2] + b0[3] * b0[3]) + (b1[0] * b1[0] + b1[1] * b1[1]) + (b1[2] * b1[2] + b1[3] * b1[3]);
                    ss += __shfl_xor(ss, 16); ss += __shfl_xor(ss, 32);
                    const float rs = __builtin_amdgcn_rsqf(ss * (1.0f / 64.0f) + 1e-6f);
#pragma unroll
                    for (int e = 0; e < 4; ++e) { a0[e] *= rs * w[0][e]; a1[e] *= rs * w[0][4 + e]; b0[e] *= rs * w[1][e]; b1[e] *= rs * w[1][4 + e]; }
                    const float pf = (float)pq[ai][m];
                    const float v0_ = __builtin_amdgcn_fractf(pf * rda0), v1_ = __builtin_amdgcn_fractf(pf * rda1);
                    const float c0 = __builtin_amdgcn_cosf(v0_), s0 = __builtin_amdgcn_sinf(v0_), c1 = __builtin_amdgcn_cosf(v1_), s1 = __builtin_amdgcn_sinf(v1_);
                    { const float t1 = a0[0], t2 = a0[2]; a0[0] = t1 * c0 - t2 * s0; a0[2] = t1 * s0 + t2 * c0; }
                    { const float t1 = a0[1], t2 = a0[3]; a0[1] = t1 * c1 - t2 * s1; a0[3] = t1 * s1 + t2 * c1; }
                    bf16_t* rp = dst + (size_t)row * 512;
                    *(GAS u32x4e*)(rp) = pack8(a0, a1); *(GAS u32x4e*)(rp + 32) = pack8(b0, b1);
                    asm volatile("" ::: "memory");
                }
        } else if (pn >= 6 && pn < 10) {
            const bool isq = pn < 8; const int j0 = 32 * (wc & 1) + 8 * fq;
            bf16_t* dst = (isq ? QR : KR) + 128 * (2 * (pn & 1) + (wc >> 1)) + j0;
            const int head = 2 * (pn & 1) + (wc >> 1); const float lgh = head == 0 ? lg0 : (head == 1 ? lg1 : (head == 2 ? lg2 : lg3));
            const float osc0 = isq ? 1.0f : KR_SCALE, lgs = isq ? lgh : -lgh;
            float rrt[8];
#pragma unroll
            for (int i = 0; i < 8; ++i) rrt[i] = __builtin_amdgcn_exp2f(-(float)(j0 + i) * (13.287712379549449f / 63.0f)) * 0.15915494309189535f;
            int pq[2][4];
#pragma unroll
            for (int ai = 0; ai < 2; ++ai)
#pragma unroll
                for (int m = 0; m < 4; ++m) pq[ai][m] = ((const GAS int*)pos)[row0 + ai * 128 + m * 16];
#pragma unroll
            for (int ai = 0; ai < 2; ++ai)
#pragma unroll
                for (int m = 0; m < 4; ++m) {
                    const int row = row0 + ai * 128 + m * 16;
                    const float pf = (float)pq[ai][m];
                    const float osc = osc0 * __builtin_amdgcn_exp2f(lgs * (float)(row & 127));
                    f32x4 t1[2] = {acc[ai][0][m][0], acc[ai][0][m][1]}, t2[2] = {acc[ai][1][m][0], acc[ai][1][m][1]}, o1[2], o2[2];
#pragma unroll
                    for (int n = 0; n < 2; ++n)
#pragma unroll
                        for (int e = 0; e < 4; ++e) { const float rv = __builtin_amdgcn_fractf(pf * rrt[4 * n + e]); const float cc = __builtin_amdgcn_cosf(rv) * osc, ss = __builtin_amdgcn_sinf(rv) * osc;
                            o1[n][e] = t1[n][e] * cc - t2[n][e] * ss; o2[n][e] = t1[n][e] * ss + t2[n][e] * cc; }
                    bf16_t* rp = dst + (size_t)row * 512;
                    *(GAS u32x4e*)(rp) = pack8(o1[0], o1[1]); *(GAS u32x4e*)(rp + 64) = pack8(o2[0], o2[1]);
                    asm volatile("" ::: "memory");
                }
        } else if (pn >= 18) {
            bf16_t* dst = GATE + 128 * (pn - 18) + wc * 32 + 8 * fq;
#pragma unroll
            for (int ai = 0; ai < 2; ++ai)
#pragma unroll
                for (int m = 0; m < 4; ++m) {
                    const int row = row0 + ai * 128 + m * 16; bf16_t* rp = dst + (size_t)row * 2048;
                    f32x4 g0 = acc[ai][0][m][0], g1 = acc[ai][0][m][1], r0 = acc[ai][1][m][0], r1 = acc[ai][1][m][1];
#pragma unroll
                    for (int e = 0; e < 4; ++e) {
                        const float ea = __builtin_amdgcn_exp2f(-1.4426950408889634f * fmaxf(r0[e], -30.0f)), eb = __builtin_amdgcn_exp2f(-1.4426950408889634f * fmaxf(r1[e], -30.0f));
                        g0[e] = sigmoidf_(g0[e]) * (1.0f + ea); g1[e] = sigmoidf_(g1[e]) * (1.0f + eb);
                        r0[e] = __builtin_amdgcn_rcpf(1.0f + ea); r1[e] = __builtin_amdgcn_rcpf(1.0f + eb); }
                    *(GAS u32x4e*)(rp) = pack8(g0, g1); *(GAS u32x4e*)(rp + 1024) = pack8(r0, r1);
                    asm volatile("" ::: "memory");
                }
        } else {
            const int act = pn < 14 ? 0 : (pn < 18 ? 1 : 2);
            const int ld = pn < 6 ? 512 : (pn < 18 ? 1024 : 2048);
            const int colt = (pn < 6 ? pn - 4 : (pn < 14 ? pn - 10 : (pn < 18 ? pn - 14 : pn - 18))) * 256;
            const size_t woff = pn < 6 ? WS_VD : (pn < 14 ? WS_VR : WS_GS);
            bf16_t* dst = (pn < 18 ? (bf16_t*)(ws + woff) : GATE) + colt + wc * 32 + 8 * fq;
#pragma unroll
            for (int ai = 0; ai < 2; ++ai)
#pragma unroll
                for (int m = 0; m < 4; ++m) {
                    const int row = row0 + ai * 128 + m * 16; bf16_t* rp = dst + (size_t)row * ld;
#pragma unroll
                    for (int bj = 0; bj < 2; ++bj) { f32x4 v0 = acc[ai][bj][m][0], v1 = acc[ai][bj][m][1];
                        if (act) {
#pragma unroll
                            for (int e = 0; e < 4; ++e) { const float s0 = sigmoidf_(v0[e]), s1 = sigmoidf_(v1[e]); v0[e] = act == 1 ? v0[e] * s0 : s0; v1[e] = act == 1 ? v1[e] * s1 : s1; } }
                        *(GAS u32x4e*)(rp + bj * 128) = pack8(v0, v1); }
                    asm volatile("" ::: "memory");
                }
        }
    }
};
struct EpiMerge2 {
    static constexpr bool PERM = true, AFTER_DRAIN = false; static constexpr int MIDK = 8; static constexpr int TAG = 5;
    const bf16_t* GATE; bf16_t* MRG;
    template <int HALF> __device__ __forceinline__ void scale(f32x4 (&acc)[2][2][4][2], const Unit& u, int wr, int wc, int fr_, int fq_) const {
        int fr = fr_, fq = fq_; asm volatile("" : "+v"(fr), "+v"(fq));
        const int row0 = u.pm * 256 + wr * 64 + fr, col0 = u.pn * 256 + wc * 32 + 8 * fq;
        u32x4e gq[2][4][2];
#pragma unroll
        for (int ai = 0; ai < 2; ++ai)
#pragma unroll
            for (int m = 0; m < 4; ++m)
#pragma unroll
                for (int bj = 0; bj < 2; ++bj) gq[ai][m][bj] = *(const GAS u32x4e*)(GATE + (size_t)(row0 + ai * 128 + m * 16) * 2048 + HALF * 1024 + col0 + bj * 128);
#pragma unroll
        for (int ai = 0; ai < 2; ++ai)
#pragma unroll
            for (int m = 0; m < 4; ++m) { const size_t row = (size_t)(row0 + ai * 128 + m * 16);
#pragma unroll
                for (int bj = 0; bj < 2; ++bj) { const int col = col0 + bj * 128;
                    const u32x4e g = gq[ai][m][bj];
                    f32x4& v0 = acc[ai][bj][m][0]; f32x4& v1 = acc[ai][bj][m][1];
                    v0[0] *= bflo(g.x); v0[1] *= bfhi(g.x); v0[2] *= bflo(g.y); v0[3] *= bfhi(g.y); v1[0] *= bflo(g.z); v1[1] *= bfhi(g.z); v1[2] *= bflo(g.w); v1[3] *= bfhi(g.w);
                    if (HALF == 1) *(GAS u32x4e*)(MRG + row * 1024 + col) = pack8(v0, v1); } }
    }
    __device__ __forceinline__ void mid(f32x4 (&acc)[2][2][4][2], const Unit& u, int wr, int wc, int fr, int fq) const { scale<0>(acc, u, wr, wc, fr, fq); }
    __device__ __forceinline__ void operator()(const f32x4 (&acc)[2][2][4][2], const Unit& u, int wr, int wc, int fr, int fq) const {
        f32x4 (&a)[2][2][4][2] = const_cast<f32x4 (&)[2][2][4][2]>(acc); scale<1>(a, u, wr, wc, fr, fq); }
};
struct EpiX1 {
    static constexpr bool PERM = true, AFTER_DRAIN = false; static constexpr int MIDK = 0; static constexpr int TAG = 6;
    const float* x; float* out; bf16_t* XN; float* rss;
    __device__ __forceinline__ void operator()(const f32x4 (&acc)[2][2][4][2], const Unit& u, int wr, int wc, int fr_, int fq_) const {
        int fr = fr_, fq = fq_; asm volatile("" : "+v"(fr), "+v"(fq));
        const int row0 = u.pm * 256 + wr * 64 + fr, col0 = u.pn * 256 + wc * 32 + 8 * fq;
#pragma unroll
        for (int ai = 0; ai < 2; ++ai) {
            f32x4 xq[4][2][2];
#pragma unroll
            for (int m = 0; m < 4; ++m)
#pragma unroll
                for (int bj = 0; bj < 2; ++bj) { const size_t off = (size_t)(row0 + ai * 128 + m * 16) * 1024 + col0 + bj * 128; xq[m][bj][0] = *(const GAS f32x4*)(x + off); xq[m][bj][1] = *(const GAS f32x4*)(x + off + 4); }
#pragma unroll
            for (int m = 0; m < 4; ++m) { const size_t row = (size_t)(row0 + ai * 128 + m * 16); float ss = 0.f;
#pragma unroll
                for (int bj = 0; bj < 2; ++bj) { const size_t off = row * 1024 + col0 + bj * 128;
                    const f32x4 v0 = acc[ai][bj][m][0] + xq[m][bj][0], v1 = acc[ai][bj][m][1] + xq[m][bj][1];
                    *(GAS u32x4e*)(XN + off) = pack8(v0, v1);
                    ss += (v0[0] * v0[0] + v0[1] * v0[1]) + (v0[2] * v0[2] + v0[3] * v0[3]) + (v1[0] * v1[0] + v1[1] * v1[1]) + (v1[2] * v1[2] + v1[3] * v1[3]); }
                ss += __shfl_xor(ss, 16); ss += __shfl_xor(ss, 32);
                if (fq == 0) ((GAS float*)rss)[row * 16 + u.pn * 4 + wc] = ss; }
        }
    }
};
struct EpiHid {
    static constexpr bool PERM = true, AFTER_DRAIN = false; static constexpr int MIDK = 0; static constexpr int TAG = 7;
    const float* rss; bf16_t* HID;
    __device__ __forceinline__ void operator()(const f32x4 (&acc)[2][2][4][2], const Unit& u, int wr, int wc, int fr_, int fq_) const {
        int fr = fr_, fq = fq_; asm volatile("" : "+v"(fr), "+v"(fq));
        const int row0 = u.pm * 256 + wr * 64 + fr, col0 = u.pn * 256 + wc * 32 + 8 * fq;
        f32x4 rq[2][4];
#pragma unroll
        for (int ai = 0; ai < 2; ++ai)
#pragma unroll
            for (int m = 0; m < 4; ++m) rq[ai][m] = *((const GAS f32x4*)(rss + (size_t)(row0 + ai * 128 + m * 16) * 16) + fq);
#pragma unroll
        for (int ai = 0; ai < 2; ++ai)
#pragma unroll
            for (int m = 0; m < 4; ++m) { const size_t row = (size_t)(row0 + ai * 128 + m * 16);
                const f32x4 r0 = rq[ai][m];
                float ssum = (r0[0] + r0[1]) + (r0[2] + r0[3]); ssum += __shfl_xor(ssum, 16); ssum += __shfl_xor(ssum, 32);
                const float rs = __builtin_amdgcn_rsqf(ssum * (1.0f / 1024.0f) + 1e-6f);
#pragma unroll
                for (int bj = 0; bj < 2; ++bj) { f32x4 v0 = acc[ai][bj][m][0] * rs, v1 = acc[ai][bj][m][1] * rs;
#pragma unroll
                    for (int e = 0; e < 4; ++e) { const float a = fmaxf(v0[e], 0.f), b = fmaxf(v1[e], 0.f); v0[e] = a * a; v1[e] = b * b; }
                    *(GAS u32x4e*)(HID + row * 4096 + col0 + bj * 128) = pack8(v0, v1); } }
    }
};
struct RevOrder : pg8::StaticOrder {
    __device__ __forceinline__ bool next(int i, pg8::Unit& u) const { const bool ok = pg8::StaticOrder::next(i, u); u.pm = nM - 1 - u.pm; return ok; }
};
struct EpiOut {
    static constexpr bool PERM = true, AFTER_DRAIN = false; static constexpr int MIDK = 0; static constexpr int TAG = 8;
    float* out; const bf16_t* XN;
    __device__ __forceinline__ void operator()(const f32x4 (&acc)[2][2][4][2], const Unit& u, int wr, int wc, int fr_, int fq_) const {
        int fr = fr_, fq = fq_; asm volatile("" : "+v"(fr), "+v"(fq));
        const int row0 = u.pm * 256 + wr * 64 + fr, col0 = u.pn * 256 + wc * 32 + 8 * fq;
        u32x4e xq[2][4][2];
#pragma unroll
        for (int ai = 0; ai < 2; ++ai)
#pragma unroll
            for (int m = 0; m < 4; ++m)
#pragma unroll
                for (int bj = 0; bj < 2; ++bj) xq[ai][m][bj] = *(const GAS u32x4e*)(XN + (size_t)(row0 + ai * 128 + m * 16) * 1024 + col0 + bj * 128);
#pragma unroll
        for (int ai = 0; ai < 2; ++ai)
#pragma unroll
            for (int m = 0; m < 4; ++m) { const size_t row = (size_t)(row0 + ai * 128 + m * 16);
#pragma unroll
                for (int bj = 0; bj < 2; ++bj) { float* p = out + row * 1024 + col0 + bj * 128; const u32x4e xr = xq[ai][m][bj];
                    f32x4 v0 = acc[ai][bj][m][0], v1 = acc[ai][bj][m][1];
                    v0[0] += bflo(xr.x); v0[1] += bfhi(xr.x); v0[2] += bflo(xr.y); v0[3] += bfhi(xr.y); v1[0] += bflo(xr.z); v1[1] += bfhi(xr.z); v1[2] += bflo(xr.w); v1[3] += bfhi(xr.w);
                    *(GAS f32x4*)(p) = v0; *(GAS f32x4*)(p + 4) = v1; } }
    }
};


namespace da {
typedef short bf16x8 __attribute__((ext_vector_type(8)));
typedef short s16x4 __attribute__((ext_vector_type(4)));
typedef float f32x16 __attribute__((ext_vector_type(16)));
typedef unsigned u32x4 __attribute__((ext_vector_type(4)));
typedef __attribute__((address_space(3))) const unsigned char* lds_cptr;
constexpr int SLOT = 32768, VOFF = 16384;
__device__ __forceinline__ int crow(int r, int hi) { return (r & 3) + 8 * (r >> 2) + 4 * hi; }
__device__ __forceinline__ void glds16(const void* gsrc, unsigned lds_dst) { unsigned keep;
    asm volatile("s_mov_b32 %0, m0\n\ts_mov_b32 m0, %2\n\ts_nop 0\n\tglobal_load_lds_dwordx4 %1, off\n\ts_mov_b32 m0, %0" : "=&s"(keep) : "v"(gsrc), "s"(lds_dst) : "memory"); }
typedef float f32x2_t __attribute__((ext_vector_type(2))); typedef __bf16 bf16x2_t __attribute__((ext_vector_type(2)));
__device__ __forceinline__ unsigned cvtpk(float lo, float hi) { f32x2_t v = {lo, hi}; bf16x2_t b = __builtin_convertvector(v, bf16x2_t); return __builtin_bit_cast(unsigned, b); }
typedef short v4i16_t __attribute__((ext_vector_type(4)));
__device__ __forceinline__ s16x4 vtr(lds_cptr p) { return __builtin_bit_cast(s16x4, __builtin_amdgcn_ds_read_tr16_b64_v4i16((__attribute__((address_space(3))) v4i16_t*)p)); }
#define DA_MFMA(a, b, c) __builtin_amdgcn_mfma_f32_32x32x16_bf16(a, b, c, 0, 0, 0)
#define DA_WAIT_BAR(N) asm volatile("s_waitcnt vmcnt(" #N ") lgkmcnt(0)\n\ts_barrier" ::: "memory")

#define DA_SB() __builtin_amdgcn_sched_barrier(0)
#define DA_PIN(x) asm volatile("" : "+v"(x))
#define DA_EX(S, A, r) do { S[r] = __builtin_amdgcn_exp2f(S[r]); A += S[r]; } while (0)
typedef const __attribute__((address_space(3))) bf16x8* lds_frag_ptr;
__device__ __forceinline__ void half_step(unsigned ka0, unsigned va0, unsigned va1, const bf16x8 (&q0)[4], const bf16x8 (&q1)[4], f32x16 (&O0)[4], f32x16 (&O1)[4], float& l0, float& l1, bool diag, int r32, int hi) {
#define DA_LDK(c, d0) (*(lds_frag_ptr)(size_t)(ka0 ^ (unsigned)((8 * (c) + 2 * (d0)) << 4)))
#define DA_VF(n) const s16x4 vl##n = vtr((lds_cptr)(size_t)((va0 + ((n) >> 2) * 4096) ^ (unsigned)(((n) & 3) << 6))), vh##n = vtr((lds_cptr)(size_t)((va1 + ((n) >> 2) * 4096) ^ (unsigned)(((n) & 3) << 6)))
#define DA_VFR(n) ((bf16x8){vl##n[0], vl##n[1], vl##n[2], vl##n[3], vh##n[0], vh##n[1], vh##n[2], vh##n[3]})
    f32x16 s0 = {}, s1 = {}; float a0 = 0.f, a1 = 0.f; u32x4 w00, w01, w10, w11;
    { const bf16x8 ka = DA_LDK(0, 0), kb = DA_LDK(0, 1), kc = DA_LDK(0, 2), kd = DA_LDK(0, 3); DA_SB();
      s0 = DA_MFMA(ka, q0[0], s0); s0 = DA_MFMA(kb, q0[1], s0); s0 = DA_MFMA(kc, q0[2], s0); s0 = DA_MFMA(kd, q0[3], s0); }
    const bf16x8 ke = DA_LDK(1, 0), kf = DA_LDK(1, 1), kg = DA_LDK(1, 2), kh_ = DA_LDK(1, 3);
    DA_SB();
    if (diag) {
#pragma unroll
        for (int r = 0; r < 16; ++r) { if (crow(r, hi) > r32) s0[r] = -INFINITY; }
    }
    DA_SB();
    s1 = DA_MFMA(ke, q1[0], s1); DA_EX(s0, a0, 0); DA_EX(s0, a0, 1); DA_PIN(s0); DA_PIN(a0); DA_SB();
    s1 = DA_MFMA(kf, q1[1], s1); DA_EX(s0, a0, 2); DA_EX(s0, a0, 3); w00.x = cvtpk(s0[0], s0[1]); w00.y = cvtpk(s0[2], s0[3]); DA_PIN(s0); DA_PIN(a0); DA_PIN(w00); DA_SB();
    DA_VF(0); DA_VF(1);
    s1 = DA_MFMA(kg, q1[2], s1); DA_EX(s0, a0, 4); DA_EX(s0, a0, 5); DA_PIN(s0); DA_PIN(a0); DA_SB();
    DA_VF(2); DA_VF(3);
    s1 = DA_MFMA(kh_, q1[3], s1); DA_EX(s0, a0, 6); DA_EX(s0, a0, 7); w00.z = cvtpk(s0[4], s0[5]); w00.w = cvtpk(s0[6], s0[7]); DA_PIN(s0); DA_PIN(a0); DA_PIN(w00); DA_SB();
    if (diag) {
#pragma unroll
        for (int r = 0; r < 16; ++r) { if (crow(r, hi) > r32) s1[r] = -INFINITY; }
    }
    DA_SB();
    const bf16x8 pa00 = __builtin_bit_cast(bf16x8, w00);
    O0[0] = DA_MFMA(pa00, DA_VFR(0), O0[0]); DA_EX(s1, a1, 0); DA_EX(s1, a1, 1); DA_PIN(s1); DA_PIN(a1); DA_SB();
    O0[1] = DA_MFMA(pa00, DA_VFR(1), O0[1]); DA_EX(s1, a1, 2); DA_EX(s1, a1, 3); w10.x = cvtpk(s1[0], s1[1]); w10.y = cvtpk(s1[2], s1[3]); DA_PIN(s1); DA_PIN(a1); DA_PIN(w10); DA_SB();
    O0[2] = DA_MFMA(pa00, DA_VFR(2), O0[2]); DA_EX(s1, a1, 4); DA_EX(s1, a1, 5); DA_PIN(s1); DA_PIN(a1); DA_SB();
    O0[3] = DA_MFMA(pa00, DA_VFR(3), O0[3]); DA_EX(s1, a1, 6); DA_EX(s1, a1, 7); w10.z = cvtpk(s1[4], s1[5]); w10.w = cvtpk(s1[6], s1[7]); DA_PIN(s1); DA_PIN(a1); DA_PIN(w10); DA_SB();
    const bf16x8 pa10 = __builtin_bit_cast(bf16x8, w10);
    O1[0] = DA_MFMA(pa10, DA_VFR(0), O1[0]); DA_EX(s0, a0, 8); DA_EX(s0, a0, 9); DA_PIN(s0); DA_PIN(a0); DA_SB();
    O1[1] = DA_MFMA(pa10, DA_VFR(1), O1[1]); DA_EX(s0, a0, 10); DA_EX(s0, a0, 11); w01.x = cvtpk(s0[8], s0[9]); w01.y = cvtpk(s0[10], s0[11]); DA_PIN(s0); DA_PIN(a0); DA_PIN(w01); DA_SB();
    DA_VF(4); DA_VF(5);
    O1[2] = DA_MFMA(pa10, DA_VFR(2), O1[2]); DA_EX(s0, a0, 12); DA_EX(s0, a0, 13); DA_PIN(s0); DA_PIN(a0); DA_SB();
    DA_VF(6); DA_VF(7);
    O1[3] = DA_MFMA(pa10, DA_VFR(3), O1[3]); DA_EX(s0, a0, 14); DA_EX(s0, a0, 15); w01.z = cvtpk(s0[12], s0[13]); w01.w = cvtpk(s0[14], s0[15]); DA_PIN(a0); DA_PIN(w01); DA_SB();
    const bf16x8 pa01 = __builtin_bit_cast(bf16x8, w01);
    O0[0] = DA_MFMA(pa01, DA_VFR(4), O0[0]); DA_EX(s1, a1, 8); DA_EX(s1, a1, 9); DA_PIN(s1); DA_PIN(a1); DA_SB();
    O0[1] = DA_MFMA(pa01, DA_VFR(5), O0[1]); DA_EX(s1, a1, 10); DA_EX(s1, a1, 11); w11.x = cvtpk(s1[8], s1[9]); w11.y = cvtpk(s1[10], s1[11]); DA_PIN(s1); DA_PIN(a1); DA_PIN(w11); DA_SB();
    O0[2] = DA_MFMA(pa01, DA_VFR(6), O0[2]); DA_EX(s1, a1, 12); DA_EX(s1, a1, 13); DA_PIN(s1); DA_PIN(a1); DA_SB();
    O0[3] = DA_MFMA(pa01, DA_VFR(7), O0[3]); DA_EX(s1, a1, 14); DA_EX(s1, a1, 15); w11.z = cvtpk(s1[12], s1[13]); w11.w = cvtpk(s1[14], s1[15]); DA_PIN(a1); DA_PIN(w11); DA_SB();
    const bf16x8 pa11 = __builtin_bit_cast(bf16x8, w11);
    O1[0] = DA_MFMA(pa11, DA_VFR(4), O1[0]); O1[1] = DA_MFMA(pa11, DA_VFR(5), O1[1]); O1[2] = DA_MFMA(pa11, DA_VFR(6), O1[2]); O1[3] = DA_MFMA(pa11, DA_VFR(7), O1[3]);
    l0 += a0; l1 += a1;
    DA_SB();
#undef DA_LDK
#undef DA_VF
#undef DA_VFR
}

__device__ __forceinline__ void attn_unit(int b, int h, int qb, const unsigned short* QD, const unsigned short* KD, const unsigned short* VD, unsigned short* OA, const float* subw, float lam,
                                          __attribute__((address_space(3))) unsigned char* shm, unsigned long long& tacc) {
#define DA_T0(k) unsigned long long tt_##k = 0; if (PROBE_TK == (k) && wid == PROBE_TW) tt_##k = __builtin_amdgcn_s_memrealtime()
#define DA_T1(k) if (PROBE_TK == (k) && wid == PROBE_TW) tacc += __builtin_amdgcn_s_memrealtime() - tt_##k
    int tid = threadIdx.x; asm volatile("" : "+v"(tid));
    const int lane = tid & 63, r32 = lane & 31, hi = lane >> 5; const int wid = __builtin_amdgcn_readfirstlane(tid >> 6);
    const size_t tok0 = (size_t)b * SEQ; const int q0 = qb * 256;
    const unsigned lds0 = (unsigned)(uintptr_t)shm;
    const int l4 = lane >> 4, rloc = 4 * wid + l4;
    const unsigned short* ksrc = KD + (tok0 + rloc) * 512 + h * 128 + ((lane & 15) ^ (rloc & 15)) * 8;
    const unsigned short* vsrc = VD + (tok0 + rloc) * 512 + h * 128 + ((lane & 15) ^ ((l4 << 2) | (wid & 3))) * 8;
    const unsigned kdst = lds0 + wid * 1024, vdst = lds0 + VOFF + wid * 1024;
#define DA_DMA(t, slot) do { const size_t o_ = (size_t)(t) * 64 * 512; \
        glds16(ksrc + o_, (unsigned)__builtin_amdgcn_readfirstlane(kdst + (slot))); glds16(ksrc + o_ + 32 * 512, (unsigned)__builtin_amdgcn_readfirstlane(kdst + (slot) + 8192)); \
        glds16(vsrc + o_, (unsigned)__builtin_amdgcn_readfirstlane(vdst + (slot))); glds16(vsrc + o_ + 32 * 512, (unsigned)__builtin_amdgcn_readfirstlane(vdst + (slot) + 8192)); } while (0)
    const int NT = 4 * (qb + 1);
    asm volatile("s_waitcnt vmcnt(0)" ::: "memory");
    DA_DMA(0, 0); DA_DMA(1, SLOT); DA_DMA(2, 2 * SLOT);
    bf16x8 q0f[4], q1f[4];
    { const unsigned short* qp = QD + (tok0 + q0 + wid * 32 + r32) * 512 + h * 128 + hi * 8;
#pragma unroll
      for (int d0 = 0; d0 < 4; ++d0) { q0f[d0] = *(const GAS bf16x8*)(qp + d0 * 16); q1f[d0] = *(const GAS bf16x8*)(qp + 64 + d0 * 16); } }
    asm volatile("" :: "v"(q0f[0]), "v"(q0f[1]), "v"(q0f[2]), "v"(q0f[3]), "v"(q1f[0]), "v"(q1f[1]), "v"(q1f[2]), "v"(q1f[3]));
    f32x16 O0[4], O1[4];
#pragma unroll
    for (int i = 0; i < 4; ++i) { O0[i] = f32x16{}; O1[i] = f32x16{}; }
    float l0 = 0.f, l1 = 0.f;
    const unsigned kab = lds0 + r32 * 256 + (((r32 & 15) ^ hi) << 4);
    unsigned vab[2];
    { const int q = (lane & 15) >> 2, p = lane & 3, g1 = (lane >> 4) & 1;
#pragma unroll
      for (int sec = 0; sec < 2; ++sec) vab[sec] = lds0 + VOFF + (4 * hi + q) * 256 + 64 * q + 16 * ((2 * g1 + (p >> 1)) ^ ((hi + 2 * sec) & 3)) + 8 * (p & 1) + sec * 2048; }
    const int HB = 2 * NT - 8;
    int slot = -SLOT, slot2 = 2 * SLOT;
    for (int hs = 0; hs < 2 * NT; ++hs) {
        const int t = hs >> 1;
        if ((hs & 1) == 0) {
            { DA_T0(1);
            if (t + 2 < NT) { DA_WAIT_BAR(8); } else if (t + 1 < NT) { DA_WAIT_BAR(4); } else { DA_WAIT_BAR(0); }
            DA_T1(1); }
            slot = slot == 3 * SLOT ? 0 : slot + SLOT; slot2 = slot2 == 3 * SLOT ? 0 : slot2 + SLOT;
            { DA_T0(2);
            if (wid < 4 && t + 3 < NT) DA_DMA(t + 3, slot2);
            DA_T1(2); }
        } else { DA_T0(2); if (wid >= 4 && t + 3 < NT) DA_DMA(t + 3, slot2); DA_T1(2); }
        const int rel = hs - HB - wid;
        if (rel <= 0) { const unsigned ho = (unsigned)(slot + (hs & 1) * 8192);
            DA_T0(3);
            half_step(kab + ho, vab[0] + ho, vab[1] + ho, q0f, q1f, O0, O1, l0, l1, rel == 0, r32, hi);
            DA_T1(3); }
    }
    DA_T0(4);
    l0 += __shfl_xor(l0, 32); l1 += __shfl_xor(l1, 32);
    asm volatile("s_waitcnt lgkmcnt(0)\n\ts_barrier" ::: "memory");
    __attribute__((address_space(3))) float* lw = (__attribute__((address_space(3))) float*)(shm + 65536) + wid * 64;
    if (hi == 0) { lw[r32] = __builtin_amdgcn_rcpf(l0); lw[32 + r32] = lam * __builtin_amdgcn_rcpf(l1); }
    asm volatile("s_waitcnt lgkmcnt(0)" ::: "memory");
    __attribute__((address_space(3))) unsigned short* stg = (__attribute__((address_space(3))) unsigned short*)(shm + wid * 8192);
    float sw[4];
#pragma unroll
    for (int db = 0; db < 4; ++db) sw[db] = ((const GAS float*)subw)[db * 32 + r32];
    float ssq[16];
#pragma unroll
    for (int r = 0; r < 16; ++r) { const float i0 = lw[crow(r, hi)], i1 = lw[32 + crow(r, hi)]; float s = 0.f;
#pragma unroll
        for (int db = 0; db < 4; ++db) { const float o = O0[db][r] * i0 - O1[db][r] * i1; O0[db][r] = o; s += o * o; }
        ssq[r] = s; }
#pragma unroll
    for (int o = 1; o < 32; o <<= 1) {
#pragma unroll
        for (int r = 0; r < 16; ++r) ssq[r] += __shfl_xor(ssq[r], o); }
#pragma unroll
    for (int r = 0; r < 16; ++r) { const float rs = (1.0f - LAMBDA_INIT) * __builtin_amdgcn_rsqf(ssq[r] * (1.0f / 128.0f) + 1e-5f); const int row = crow(r, hi);
#pragma unroll
        for (int db = 0; db < 4; ++db) stg[row * 128 + db * 32 + r32] = (unsigned short)cvtpk(O0[db][r] * rs * sw[db], 0.f); }
    asm volatile("s_waitcnt lgkmcnt(0)" ::: "memory");
    unsigned short* Ow = OA + (tok0 + q0 + wid * 32) * 1536 + h * 128;
#pragma unroll
    for (int i = 0; i < 8; ++i) { const int row = i * 4 + (lane >> 4), ch = lane & 15;
        const u32x4 v = *(const __attribute__((address_space(3))) u32x4*)(stg + row * 128 + ch * 8);
        *(GAS u32x4*)(Ow + (size_t)row * 1536 + ch * 8) = v; }
    asm volatile("s_waitcnt lgkmcnt(0)\n\ts_barrier" ::: "memory");
    DA_T1(4);
#undef DA_DMA
#undef DA_T0
#undef DA_T1
}
#undef DA_MFMA
#undef DA_WAIT_BAR
#undef DA_SB
#undef DA_PIN
#undef DA_EX
}

__device__ __forceinline__ void attn_phase(Frame& F, const Args& A) {
    const unsigned short* QD = (const unsigned short*)(F.ws + WS_QD); const unsigned short* KD = (const unsigned short*)(F.ws + WS_KD); const unsigned short* VD = (const unsigned short*)(F.ws + WS_VD);
    unsigned short* OA = (unsigned short*)(F.ws + WS_OA);
    const float lam = ((const GAS float*)(F.ws + WS_MISC))[0]; const float* subw = (const float*)A.in[10];
    const int bx = blockIdx.x, G = F.G;
    for (int it0 = (G % 8 == 0) ? (bx % 8) * (G / 8) + bx / 8 : bx; it0 < 256; it0 += G) {
        const int bh = it0 >> 3, s = it0 & 7, b = bh >> 2, h = bh & 3;
        for (int u = 0; u < 2; ++u) da::attn_unit(b, h, u == 0 ? 15 - s : s, QD, KD, VD, OA, subw, lam, F.lds, F.tacc);
    }
}


namespace rtn {
using da::bf16x8; using da::s16x4; using da::f32x16; using da::u32x4; using da::lds_cptr; using da::glds16; using da::cvtpk; using da::vtr; using da::crow;
#define RT_MFMA(a, b, c) __builtin_amdgcn_mfma_f32_32x32x16_bf16(a, b, c, 0, 0, 0)
#define RT_SB() __builtin_amdgcn_sched_barrier(0)
constexpr int KIMG = 0, VIMG = 32768, STATS = 98304;

__device__ __forceinline__ void dma_v(const unsigned short* VR, size_t tok0, int h, int wid, int lane, unsigned lds0) {
    const unsigned short* src = VR + (tok0 + 16 * wid + (lane >> 2)) * 1024 + h * 256 + (lane & 3) * 8;
#pragma unroll
    for (int i = 0; i < 8; ++i) glds16(src + i * 32, (unsigned)__builtin_amdgcn_readfirstlane(lds0 + VIMG + i * 8192 + wid * 1024));
}

__device__ __forceinline__ void stage_a_item(int item, const unsigned short* KR, const unsigned short* VR, unsigned short* KV, __attribute__((address_space(3))) unsigned char* shm) {
    int tid = threadIdx.x; asm volatile("" : "+v"(tid));
    const int lane = tid & 63, hi = lane >> 5; const int wid = __builtin_amdgcn_readfirstlane(tid >> 6);
    const int j = item & 31, bh = item >> 5, h = bh & 3, b = bh >> 2;
    const size_t tok0 = (size_t)b * SEQ + j * 128;
    const unsigned lds0 = (unsigned)(uintptr_t)shm;
    asm volatile("s_waitcnt vmcnt(0)" ::: "memory");
    { const unsigned short* src = KR + (tok0 + 16 * wid + (lane >> 2)) * 512 + h * 128 + (lane & 3) * 8;
#pragma unroll
      for (int i = 0; i < 4; ++i) glds16(src + i * 32, (unsigned)__builtin_amdgcn_readfirstlane(lds0 + KIMG + i * 8192 + wid * 1024)); }
    dma_v(VR, tok0, h, wid, lane, lds0);
    asm volatile("s_waitcnt vmcnt(0)\n\ts_barrier" ::: "memory");
    const lds_cptr trb = (lds_cptr)shm + ((lane >> 4) & 1) * 32 + (lane & 3) * 8 + (4 * hi + ((lane & 15) >> 2)) * 64;
    bf16x8 vf[8];
#pragma unroll
    for (int ks = 0; ks < 8; ++ks) { const s16x4 lo = vtr(trb + VIMG + wid * 8192 + ks * 1024), hh = vtr(trb + VIMG + wid * 8192 + ks * 1024 + 512);
        vf[ks] = (bf16x8){lo[0], lo[1], lo[2], lo[3], hh[0], hh[1], hh[2], hh[3]}; }
    unsigned short* dst = KV + (size_t)item * 32768 + (size_t)wid * 64 * 16 + lane * 16;
#pragma unroll
    for (int kb = 0; kb < 4; ++kb) {
        f32x16 acc = {};
#pragma unroll
        for (int ks = 0; ks < 8; ++ks) { const s16x4 lo = vtr(trb + KIMG + kb * 8192 + ks * 1024), hh = vtr(trb + KIMG + kb * 8192 + ks * 1024 + 512);
            const bf16x8 kf = (bf16x8){lo[0], lo[1], lo[2], lo[3], hh[0], hh[1], hh[2], hh[3]};
            acc = RT_MFMA(kf, vf[ks], acc); }
        u32x4 w0, w1;
        w0.x = cvtpk(acc[0], acc[1]); w0.y = cvtpk(acc[2], acc[3]); w0.z = cvtpk(acc[4], acc[5]); w0.w = cvtpk(acc[6], acc[7]);
        w1.x = cvtpk(acc[8], acc[9]); w1.y = cvtpk(acc[10], acc[11]); w1.z = cvtpk(acc[12], acc[13]); w1.w = cvtpk(acc[14], acc[15]);
        *(GAS u32x4*)(dst + (size_t)kb * 8 * 64 * 16) = w0; *(GAS u32x4*)(dst + (size_t)kb * 8 * 64 * 16 + 8) = w1;
    }
    asm volatile("s_waitcnt lgkmcnt(0)\n\ts_barrier" ::: "memory");
}

__device__ __forceinline__ void stage_b(const unsigned short* KV, unsigned short* ST, float lg0, float lg1, float lg2_, float lg3, int G) {
    const int NT = G * NWAVES * 64;
    for (int gt = blockIdx.x * (NWAVES * 64) + threadIdx.x; gt < BATCH * 4 * 4096; gt += NT) {
        const int bh = gt >> 12, e = gt & 4095, h = bh & 3;
        const float lg2 = h == 0 ? lg0 : (h == 1 ? lg1 : (h == 2 ? lg2_ : lg3)), g1 = exp2f(lg2), g127 = exp2f(127.0f * lg2), g128 = exp2f(128.0f * lg2);
        const GAS u32x4* src = (const GAS u32x4*)(KV + (size_t)bh * 32 * 32768) + e; GAS u32x4* dst = (GAS u32x4*)(ST + (size_t)bh * 32 * 32768) + e;
        float a[8];
#pragma unroll
        for (int i = 0; i < 8; ++i) a[i] = 0.f;
#pragma unroll 8
        for (int j = 0; j < 32; ++j) {
            u32x4 o; o.x = cvtpk(a[0] * g1, a[1] * g1); o.y = cvtpk(a[2] * g1, a[3] * g1); o.z = cvtpk(a[4] * g1, a[5] * g1); o.w = cvtpk(a[6] * g1, a[7] * g1);
            dst[(size_t)j * 4096] = o;
            if (j < 31) { const u32x4 k = src[(size_t)j * 4096];
                a[0] = g128 * a[0] + g127 * bflo(k.x); a[1] = g128 * a[1] + g127 * bfhi(k.x); a[2] = g128 * a[2] + g127 * bflo(k.y); a[3] = g128 * a[3] + g127 * bfhi(k.y);
                a[4] = g128 * a[4] + g127 * bflo(k.z); a[5] = g128 * a[5] + g127 * bfhi(k.z); a[6] = g128 * a[6] + g127 * bflo(k.w); a[7] = g128 * a[7] + g127 * bfhi(k.w); }
        }
    }
}

constexpr int STG = STATS + 2048;
__device__ __forceinline__ void dma_c(int item, const unsigned short* KR, const unsigned short* VR, int wid, int lane, unsigned lds0) {
    const int j = item & 31, bh = item >> 5, h = bh & 3, b = bh >> 2;
    const size_t tok0 = (size_t)b * SEQ + j * 128;
    const unsigned short* src = KR + (tok0 + 64 * (wid & 1) + lane) * 512 + h * 128 + (wid >> 1) * 8;
#pragma unroll
    for (int i = 0; i < 4; ++i) glds16(src + i * 32, (unsigned)__builtin_amdgcn_readfirstlane(lds0 + KIMG + (wid + 8 * i) * 1024));
    dma_v(VR, tok0, h, wid, lane, lds0);
}
__device__ __forceinline__ void stage_c_items(int item0, int NI, const unsigned short* QR, const unsigned short* KR, const unsigned short* VR, const unsigned short* ST, const unsigned short* GS, const float* gnw,
                                              unsigned short* ORR, __attribute__((address_space(3))) unsigned char* shm, unsigned long long& tacc) {
    const int wid = __builtin_amdgcn_readfirstlane(threadIdx.x >> 6), rb = wid >> 1, dh = wid & 1;
    unsigned long long tt_ = 0;
#define RC_T0(k) do { if (PROBE_TK == (k) && wid == PROBE_TW) { RT_SB(); tt_ = __builtin_amdgcn_s_memrealtime(); RT_SB(); } } while (0)
#define RC_T1(k) do { if (PROBE_TK == (k) && wid == PROBE_TW) { RT_SB(); tacc += __builtin_amdgcn_s_memrealtime() - tt_; RT_SB(); } } while (0)
    const unsigned lds0 = (unsigned)(uintptr_t)shm;
    asm volatile("s_waitcnt vmcnt(0) lgkmcnt(0)\n\ts_barrier" ::: "memory");
    dma_c(item0, KR, VR, wid, threadIdx.x & 63, lds0);
    for (int ii = 0; ii < NI; ++ii) {
        int tid = threadIdx.x; asm volatile("" : "+v"(tid));
        const int lane = tid & 63, r32 = lane & 31, hi = lane >> 5;
        const int item = item0 + ii, j = item & 31, bh = item >> 5, h = bh & 3, b = bh >> 2;
        const size_t tok0 = (size_t)b * SEQ + j * 128;
        RC_T0(21);
        bf16x8 qn[8];
        { const unsigned short* qp = QR + (tok0 + 32 * rb + r32) * 512 + h * 128 + hi * 8;
#pragma unroll
          for (int s = 0; s < 8; ++s) qn[s] = *(const GAS bf16x8*)(qp + s * 16); }
        f32x16 O[4];
#pragma unroll
        for (int i = 0; i < 4; ++i) O[i] = f32x16{};
        if (j > 0) {
            const unsigned short* sp = ST + (size_t)item * 32768 + (size_t)(4 * dh) * 64 * 16 + lane * 16;
            bf16x8 fa[2][4], fb[2][4];
#define RC_LOAD(f, q) do { _Pragma("unroll") for (int s2 = 0; s2 < 2; ++s2) _Pragma("unroll") for (int db = 0; db < 4; ++db) f[s2][db] = *(const GAS bf16x8*)(sp + (size_t)((q) * 8 + db) * 64 * 16 + s2 * 8); } while (0)
#define RC_USE(f, q) do { _Pragma("unroll") for (int s2 = 0; s2 < 2; ++s2) { const u32x4 qv = __builtin_bit_cast(u32x4, qn[2 * (q) + s2]); \
                const auto r0 = __builtin_amdgcn_permlane32_swap(qv.x, qv.z, false, false), r1 = __builtin_amdgcn_permlane32_swap(qv.y, qv.w, false, false); \
                u32x4 pv; pv.x = r0[0]; pv.y = r1[0]; pv.z = r0[1]; pv.w = r1[1]; const bf16x8 qa = __builtin_bit_cast(bf16x8, pv); \
                _Pragma("unroll") for (int db = 0; db < 4; ++db) O[db] = RT_MFMA(qa, f[s2][db], O[db]); } } while (0)
            RC_LOAD(fa, 0); RC_LOAD(fb, 1); RT_SB();
            RC_USE(fa, 0); RT_SB(); RC_LOAD(fa, 2); RT_SB();
            RC_USE(fb, 1); RT_SB(); RC_LOAD(fb, 3); RT_SB();
            RC_USE(fa, 2); RT_SB(); RC_USE(fb, 3); RT_SB();
#undef RC_LOAD
#undef RC_USE
        }
        RC_T1(21); RC_T0(22);
        asm volatile("s_waitcnt vmcnt(0)\n\ts_barrier" ::: "memory");
        RC_T1(22); RC_T0(23);
        const size_t obase = (tok0 + 32 * rb) * 1024 + h * 256 + 128 * dh;
        u32x4 gpre[8];
#pragma unroll
        for (int i = 0; i < 8; ++i) { const int hf = i >> 2, row = (i & 3) * 8 + (lane >> 3), ch = lane & 7; gpre[i] = *(const GAS u32x4*)(GS + obase + (size_t)row * 1024 + hf * 64 + ch * 8); }
        const lds_cptr kp = (lds_cptr)shm + KIMG + hi * 2048 + r32 * 16;
        const lds_cptr vp = (lds_cptr)shm + VIMG + (4 * dh) * 8192 + ((lane >> 4) & 1) * 32 + (lane & 3) * 8 + (4 * hi + ((lane & 15) >> 2)) * 64;
        for (int kb = 0; kb <= rb; ++kb) {
            f32x16 s = {};
#pragma unroll
            for (int ks = 0; ks < 8; ++ks) { const bf16x8 kf = *(const __attribute__((address_space(3))) bf16x8*)(kp + ks * 4096 + kb * 512); s = RT_MFMA(kf, qn[ks], s); }
            if (kb == rb) {
#pragma unroll
                for (int r = 0; r < 16; ++r) { if (crow(r, hi) > r32) s[r] = 0.f; }
            }
            RT_SB();
            u32x4 w0, w1;
            w0.x = cvtpk(s[0], s[1]); w0.y = cvtpk(s[2], s[3]); w0.z = cvtpk(s[4], s[5]); w0.w = cvtpk(s[6], s[7]);
            w1.x = cvtpk(s[8], s[9]); w1.y = cvtpk(s[10], s[11]); w1.z = cvtpk(s[12], s[13]); w1.w = cvtpk(s[14], s[15]);
            const bf16x8 pa0 = __builtin_bit_cast(bf16x8, w0), pa1 = __builtin_bit_cast(bf16x8, w1);
#pragma unroll
            for (int i = 0; i < 8; ++i) { const int ks2 = i >> 2, db = i & 3;
                const s16x4 lo = vtr(vp + db * 8192 + (2 * kb + ks2) * 1024), hh = vtr(vp + db * 8192 + (2 * kb + ks2) * 1024 + 512);
                const bf16x8 vf = (bf16x8){lo[0], lo[1], lo[2], lo[3], hh[0], hh[1], hh[2], hh[3]};
                O[db] = RT_MFMA(ks2 == 0 ? pa0 : pa1, vf, O[db]); }
            RT_SB();
        }
        RC_T1(23); RC_T0(24);
        float s1[16], s2[16];
#pragma unroll
        for (int r = 0; r < 16; ++r) { float a = 0.f, q = 0.f;
#pragma unroll
            for (int db = 0; db < 4; ++db) { a += O[db][r]; q += O[db][r] * O[db][r]; }
            s1[r] = a; s2[r] = q; }
#pragma unroll
        for (int o = 1; o < 32; o <<= 1) {
#pragma unroll
            for (int r = 0; r < 16; ++r) { s1[r] += __shfl_xor(s1[r], o); s2[r] += __shfl_xor(s2[r], o); } }
        typedef float f32x2v __attribute__((ext_vector_type(2)));
        __attribute__((address_space(3))) f32x2v* stt = (__attribute__((address_space(3))) f32x2v*)(shm + STATS);
        if (r32 == 0) {
#pragma unroll
            for (int r = 0; r < 16; ++r) stt[wid * 32 + crow(r, hi)] = (f32x2v){s1[r], s2[r]};
        }
        RC_T1(24); RC_T0(25);
        asm volatile("s_waitcnt vmcnt(0) lgkmcnt(0)\n\ts_barrier" ::: "memory");
        RC_T1(25); RC_T0(26);
        float gw[2][2];
#pragma unroll
        for (int hf = 0; hf < 2; ++hf)
#pragma unroll
            for (int d2 = 0; d2 < 2; ++d2) gw[hf][d2] = ((const GAS float*)gnw)[h * 256 + 128 * dh + hf * 64 + d2 * 32 + r32];
        asm volatile("" :: "v"(gw[0][0]), "v"(gw[0][1]), "v"(gw[1][0]), "v"(gw[1][1]), "v"(gpre[0]), "v"(gpre[1]), "v"(gpre[2]), "v"(gpre[3]), "v"(gpre[4]), "v"(gpre[5]), "v"(gpre[6]), "v"(gpre[7]));
        if (ii + 1 < NI) dma_c(item + 1, KR, VR, wid, lane, lds0);
        __attribute__((address_space(3))) unsigned short* stg = (__attribute__((address_space(3))) unsigned short*)(shm + STG + wid * 4096);
        float mu_[16], rs_[16];
#pragma unroll
        for (int r = 0; r < 16; ++r) { const int row = crow(r, hi); const f32x2v pa = stt[wid * 32 + row], pb = stt[(wid ^ 1) * 32 + row];
            const float mu = (pa.x + pb.x) * (1.0f / 256.0f), var = (pa.y + pb.y) * (1.0f / 256.0f) - mu * mu; mu_[r] = mu; rs_[r] = __builtin_amdgcn_rsqf(var + 1e-5f); }
#pragma unroll
        for (int hf = 0; hf < 2; ++hf) {
#pragma unroll
            for (int r = 0; r < 16; ++r) { const int row = crow(r, hi);
#pragma unroll
                for (int d2 = 0; d2 < 2; ++d2) stg[row * 64 + d2 * 32 + r32] = (unsigned short)cvtpk((O[2 * hf + d2][r] - mu_[r]) * rs_[r] * gw[hf][d2], 0.f); }
            asm volatile("s_waitcnt lgkmcnt(0)" ::: "memory");
#pragma unroll
            for (int i = 0; i < 4; ++i) { const int row = i * 8 + (lane >> 3), ch = lane & 7;
                const u32x4 v = *(const __attribute__((address_space(3))) u32x4*)(stg + row * 64 + ch * 8);
                const u32x4 g = gpre[hf * 4 + i];
                u32x4 o; o.x = cvtpk(bflo(v.x) * bflo(g.x), bfhi(v.x) * bfhi(g.x)); o.y = cvtpk(bflo(v.y) * bflo(g.y), bfhi(v.y) * bfhi(g.y));
                o.z = cvtpk(bflo(v.z) * bflo(g.z), bfhi(v.z) * bfhi(g.z)); o.w = cvtpk(bflo(v.w) * bflo(g.w), bfhi(v.w) * bfhi(g.w));
                *(GAS u32x4*)(ORR + (tok0 + 32 * rb + row) * 1536 + 512 + h * 256 + 128 * dh + hf * 64 + ch * 8) = o; }
            asm volatile("s_waitcnt lgkmcnt(0)" ::: "memory");
        }
        RC_T1(26);
    }
    asm volatile("s_waitcnt vmcnt(0) lgkmcnt(0)\n\ts_barrier" ::: "memory");
#undef RC_T0
#undef RC_T1
}
#undef RT_MFMA
#undef RT_SB
}

__device__ __forceinline__ int vcu_of(int bx, int G) { return (G % 8 == 0) ? (bx % 8) * (G / 8) + bx / 8 : bx; }
__device__ __forceinline__ void ret_a_phase(Frame& F) {
    for (int it = 4 * vcu_of(blockIdx.x, F.G); it < BATCH * 4 * 32; it += 4 * F.G)
        for (int k = 0; k < 4; ++k) rtn::stage_a_item(it + k, (const unsigned short*)(F.ws + WS_KR), (const unsigned short*)(F.ws + WS_VR), (unsigned short*)(F.ws + WS_KV), F.lds);
}
__device__ __forceinline__ void ret_c_phase(Frame& F, const Args& A) {
    for (int it = 4 * vcu_of(blockIdx.x, F.G); it < BATCH * 4 * 32; it += 4 * F.G)
        rtn::stage_c_items(it, 4, (const unsigned short*)(F.ws + WS_QR), (const unsigned short*)(F.ws + WS_KR), (const unsigned short*)(F.ws + WS_VR), (const unsigned short*)(F.ws + WS_ST),
                           (const unsigned short*)(F.ws + WS_GS), (const float*)A.in[12], (unsigned short*)(F.ws + WS_OA), F.lds, F.tacc);
}


__global__ void __launch_bounds__(NWAVES * 64, 2) hybrid_fwd(Args args) {
    extern __shared__ __attribute__((aligned(16))) unsigned char lds[];
    Frame F;
    F.lds = (LAS unsigned char*)lds; F.MISC = (volatile LAS unsigned*)(F.lds + MISC_OFF);
    F.tid = threadIdx.x; F.lane = F.tid & 63; F.wave = __builtin_amdgcn_readfirstlane(F.tid >> 6); F.G = gridDim.x;
    F.ws = args.ws; F.ctl = (gu32*)(args.ws + WS_CTL); F.tacc = 0;
    for (int u = F.tid; u < (LDS_BYTES - MISC_OFF) / 4; u += NWAVES * 64) ((LAS unsigned*)(F.lds + MISC_OFF))[u] = 0u;
    __syncthreads();
    XcdBarrier bar; bar.bar = (unsigned*)(F.ctl + CW_BAR) + args.li * XCD_BAR_WORDS; bar.x = 0; bar.st = nullptr;
    if (MK_N_LAUNCHES != N_PHASES) bar = xcd_barrier_post((unsigned*)(F.ctl + CW_BAR) + args.li * XCD_BAR_WORDS, F.MISC + 8);
    const int lo = args.ph_lo, hi = args.ph_hi;
#define IN(k) (lo <= (k) && (k) < hi)
#ifndef PROBE_CLK
#define PROBE_CLK -1
#define PROBE_CLK_E -1
#define PROBE_CLK_DUR 0
#endif
    unsigned long long clk_m0 = 0, clk_r0 = 0, clk_ticks = 0;
#define CLK_BEG(k) do { if (PROBE_CLK == (k) && blockIdx.x == 0) { clk_m0 = __builtin_amdgcn_s_memtime(); clk_r0 = __builtin_amdgcn_s_memrealtime(); } } while (0)
#define CLK_END(k) do { if (PROBE_CLK_E == (k) && blockIdx.x == 0) { const unsigned long long dm = __builtin_amdgcn_s_memtime() - clk_m0, dr = __builtin_amdgcn_s_memrealtime() - clk_r0; clk_ticks = PROBE_CLK_DUR ? dr : (unsigned long long)((double)dm * 1000.0 / (double)dr); } } while (0)
#ifndef PROBE_BAR2
#define PROBE_BAR2 0
#endif
#define SEAM(k) do { if (IN(k) && IN((k) + 1)) { xcd_barrier(bar); if (PROBE_BAR2) xcd_barrier(bar); } } while (0)
#ifndef PROBE_DUP
#define PROBE_DUP 0
#endif
#define REP(k) for (int rep_ = 0; rep_ < 1 + ((PROBE_DUP >> (k)) & 1); ++rep_)
#define PHASE_WS() unsigned char* ws = args.ws; asm volatile("" : "+s"(ws)); F.ws = ws
    if (IN(0)) { PHASE_WS(); CLK_BEG(0); REP(0) p0_prologue(F, args); CLK_END(0); SEAM(0); }
    if (IN(1)) { PHASE_WS(); CLK_BEG(1); REP(1) {
        pg8::Gemm g{(const bf16_t*)(ws + WS_XN), (const bf16_t*)(ws + WS_WIN), M, INW, DM}; pg8::StaticOrder S; S.init(M, INW, F.G, (int)blockIdx.x);
        EpiProj E{(bf16_t*)(ws + WS_QD), (bf16_t*)(ws + WS_KD), (bf16_t*)(ws + WS_QR), (bf16_t*)(ws + WS_KR), (bf16_t*)args.out, ws,
                  (const int*)args.in[1], (const float*)args.in[4], (const float*)args.in[5], args.lg2[0], args.lg2[1], args.lg2[2], args.lg2[3]};
        pg8::gemm_phase<EpiProj, pg8::StaticOrder, true, true>(F.lds, g, S, E); }
        CLK_END(1); SEAM(1);
    }
    if (IN(2)) { PHASE_WS(); CLK_BEG(2); REP(2) attn_phase(F, args); CLK_END(20); CLK_BEG(21); REP(9) ret_a_phase(F); CLK_END(2); SEAM(2); }
    if (IN(3)) { PHASE_WS(); CLK_BEG(3); REP(3) rtn::stage_b((const unsigned short*)(ws + WS_KV), (unsigned short*)(ws + WS_ST), args.lg2[0], args.lg2[1], args.lg2[2], args.lg2[3], F.G); CLK_END(3); SEAM(3); }
    if (IN(4)) { PHASE_WS(); CLK_BEG(4); REP(4) ret_c_phase(F, args); CLK_END(4); SEAM(4); }
    if (IN(5)) { PHASE_WS(); CLK_BEG(5); REP(5) {
        pg8::Gemm g{(const bf16_t*)(ws + WS_OA), (const bf16_t*)(ws + WS_WA), M, DM, 1536}; pg8::StaticOrder S; S.init(M, DM, F.G, (int)blockIdx.x);
        EpiMerge2 E{(const bf16_t*)args.out, (bf16_t*)(ws + WS_MRG)};
        pg8::gemm_phase<EpiMerge2, pg8::StaticOrder, true, true>(F.lds, g, S, E); }
        CLK_END(5); SEAM(5);
    }
    if (IN(6)) { PHASE_WS(); CLK_BEG(6); REP(6) {
        pg8::Gemm g{(const bf16_t*)(ws + WS_MRG), (const bf16_t*)(ws + WS_WO), M, DM, DM}; pg8::StaticOrder S; S.init(M, DM, F.G, (int)blockIdx.x);
        EpiX1 E{(const float*)args.in[0], args.out, (bf16_t*)(ws + WS_XN), (float*)(ws + WS_RSS)};
        pg8::gemm_phase<EpiX1, pg8::StaticOrder, true, true>(F.lds, g, S, E); }
        CLK_END(6); SEAM(6);
    }
    if (IN(7)) { PHASE_WS(); CLK_BEG(7);
#if PROBE_XCC
        { const unsigned xcc = xb_xcc_id(); if (xcc != (blockIdx.x & 7u)) { if (F.tid == 0) { ((GAS float*)(ws + WS_RSS))[0] = __builtin_nanf(""); } } }
#endif
        for (int hf_ = 0; hf_ < 2; ++hf_) {
            int hf = hf_; asm volatile("" : "+s"(hf));
            const size_t r0 = (size_t)hf * (M / 2);
            { pg8::Gemm g{(const bf16_t*)(ws + WS_XN) + r0 * DM, (const bf16_t*)(ws + WS_W1), M / 2, FF, DM}; pg8::StaticOrder S; S.init(M / 2, FF, F.G, (int)blockIdx.x);
              EpiHid E{(const float*)(ws + WS_RSS) + r0 * 16, (bf16_t*)(ws + WS_HID) + r0 * FF};
              pg8::gemm_phase<EpiHid, pg8::StaticOrder, true, true>(F.lds, g, S, E); }
            xcd_barrier(bar);
            { pg8::Gemm g{(const bf16_t*)(ws + WS_HID) + r0 * FF, (const bf16_t*)(ws + WS_W2), M / 2, DM, FF}; RevOrder S; S.init(M / 2, DM, F.G, (int)blockIdx.x);
              EpiOut E{args.out + r0 * DM, (const bf16_t*)(ws + WS_XN) + r0 * DM};
              pg8::gemm_phase<EpiOut, RevOrder, true, true>(F.lds, g, S, E); }
        }
        CLK_END(7);
    }
    if (PROBE_TK > 0 && blockIdx.x == 0 && F.wave == PROBE_TW) { const unsigned long long t0 = __builtin_amdgcn_s_memrealtime(), tk = (PROBE_TK >= 5 && PROBE_TK < 20 ? (unsigned long long)*(LAS unsigned*)(F.lds + LDS_BYTES - 128) : F.tacc) * PROBE_TS; while (__builtin_amdgcn_s_memrealtime() - t0 < tk) __builtin_amdgcn_s_sleep(20); }
    if (PROBE_CLK >= 0 && blockIdx.x == 0 && F.wave == 0) { const unsigned long long t0 = __builtin_amdgcn_s_memrealtime(); while (__builtin_amdgcn_s_memrealtime() - t0 < clk_ticks) __builtin_amdgcn_s_sleep(20); }
#undef IN
#undef SEAM
}

extern "C" void kernel_launch(void* const* d_in, const int* in_sizes, int n_in, void* d_out, int out_size, void* d_ws, size_t ws_size, hipStream_t stream) {
    static int grid = 0;
    if (grid == 0) {
        if (n_in != 18 || in_sizes[0] != M * DM || out_size != M * DM || ws_size < WS_END) { fprintf(stderr, "kernel_launch: unexpected shapes (n_in %d, in0 %d, out %d, ws %zu)\n", n_in, n_in > 0 ? in_sizes[0] : -1, out_size, ws_size); grid = -1; return; }
        int dev = 0, cus = 0;
        if (hipGetDevice(&dev) != hipSuccess || hipDeviceGetAttribute(&cus, hipDeviceAttributeMultiprocessorCount, dev) != hipSuccess) { grid = -1; return; }
        if (hipFuncSetAttribute((const void*)hybrid_fwd, hipFuncAttributeMaxDynamicSharedMemorySize, LDS_BYTES) != hipSuccess) { fprintf(stderr, "kernel_launch: hipFuncSetAttribute failed\n"); grid = -1; return; }
        int per_cu = 0;
        if (hipOccupancyMaxActiveBlocksPerMultiprocessor(&per_cu, (const void*)hybrid_fwd, NWAVES * 64, LDS_BYTES) != hipSuccess || per_cu < 1) fprintf(stderr, "kernel_launch: occupancy query says %d\n", per_cu);
        (void)hipGetLastError();
        grid = cus;
    }
    if (grid < 0) return;
    hipMemsetAsync((char*)d_ws + WS_CTL, 0, CTL_ZERO_BYTES, stream);
    Args a{};
    for (int i = 0; i < 18; ++i) a.in[i] = d_in[i];
    a.out = (float*)d_out; a.ws = (unsigned char*)d_ws;
    for (int j = 0; j < 8; ++j) a.invf[j] = std::pow(500000.0, -(double)(2 * j) / 16.0);
    for (int j = 0; j < 64; ++j) a.invf[8 + j] = 1.0 / std::pow(10000.0, (double)j / 63.0);
    for (int hh = 0; hh < 4; ++hh) a.lg2[hh] = (float)std::log2(1.0 - std::exp2(-5.0 - (double)hh));
    const int nl = MK_N_LAUNCHES;
    for (int li = 0; li < nl; ++li) {
        if (nl == N_PHASES) { a.ph_lo = li; a.ph_hi = li + 1; a.li = 0; }
        else { a.ph_lo = li * N_PHASES / nl; a.ph_hi = (li + 1) * N_PHASES / nl; a.li = li; }
        hipLaunchKernelGGL(hybrid_fwd, dim3(grid), dim3(NWAVES * 64), LDS_BYTES, stream, a);
    }
}
```

```cpp
#include <hip/hip_runtime.h>
#include <cstdio>
#include <cstdint>
#include <cmath>
namespace pg8 {
#define PG8_LAS __attribute__((address_space(3)))
typedef unsigned short bf16_t;
typedef short bf16x8 __attribute__((ext_vector_type(8)));
typedef float f32x4 __attribute__((ext_vector_type(4)));
typedef unsigned u32x4 __attribute__((ext_vector_type(4)));
constexpr int BM = 256, BK = 64, HALF = 128, HTB = HALF * BK * 2  , STAGE_BYTES = 8 * HTB, NXCD = 8, WGM = 8;

__host__ __device__ __forceinline__ int lds_byte(int r, int c) { const int st = (r >> 4) * 2 + (c >> 5), rr = r & 15, cc = c & 31, ob = rr * 64 + cc * 2; return st * 1024 + (ob ^ (((ob >> 9) & 1) << 5)); }
__host__ __device__ __forceinline__ void stage_rc(int b, int& R, int& C) { const int st = b / 1024, sb = b % 1024, swz = sb ^ (((sb >> 9) & 1) << 5); R = (st >> 1) * 16 + swz / 64; C = (st & 1) * 32 + (swz % 64) / 2; }
__host__ __device__ __forceinline__ int perm32(int rho) { const int n = rho >> 4, i = rho & 15; return 8 * (i >> 2) + 4 * n + (i & 3); }

struct Unit { int pm, pn; };
struct Gemm { const bf16_t* A; const bf16_t* Bt; int M, N, K; };

struct StaticOrder {
    int nM, nN, nwg, G, c;
    __host__ __device__ void init(int M, int N, int G_, int c_) { nM = M / BM; nN = N / BM; nwg = nM * nN; G = G_; c = c_; }
    __host__ __device__ bool next(int i, Unit& u) const {
        const long L = (long)i * G + c; if (L >= nwg) return false;
        int wgid = (int)L; { const int q = nwg / NXCD, r = nwg % NXCD, xcd = wgid % NXCD, off = wgid / NXCD; wgid = (xcd < r ? xcd * (q + 1) : r * (q + 1) + (xcd - r) * q) + off; }
        const int nig = WGM * nN, gid = wgid / nig, fm = gid * WGM, gsz = (nM - fm) < WGM ? (nM - fm) : WGM;
        u.pm = fm + ((wgid % nig) % gsz); u.pn = (wgid % nig) / gsz; return true;
    }
    __device__ __forceinline__ void a_ready(const Unit&) const {}
    __device__ __forceinline__ void done(const Unit&) const {}
};

__device__ __forceinline__ unsigned cvt_pk_bf16(float lo, float hi) { unsigned r; asm volatile("v_cvt_pk_bf16_f32 %0, %1, %2" : "=v"(r) : "v"(lo), "v"(hi)); return r; }
typedef float f32x2 __attribute__((ext_vector_type(2)));
#define PROBE_TK 0
#define PROBE_TAG 1
#define PROBE_TW 0
#define PROBE_TS 1
template <class Epi, class Sched, bool ALIGN_EPI = false, bool SP2 = false>
__device__ __forceinline__ void gemm_phase(PG8_LAS unsigned char* lds, const Gemm g, const Sched& S, const Epi& E) {
    int tid_ = threadIdx.x; asm volatile("" : "+v"(tid_));
    const int tid = tid_, wid = __builtin_amdgcn_readfirstlane(tid >> 6), lane = tid & 63, wr = wid >> 2, wc = wid & 3, fr = lane & 15, fq = lane >> 4;
    const int K = g.K, nt = K / BK;
    unsigned voffA[2], voffB[2];
#pragma unroll
    for (int i = 0; i < 2; ++i) { int R, C; stage_rc(tid * 16 + i * 8192, R, C); const int Rb = Epi::PERM ? ((R & ~31) + perm32(R & 31)) : R;
        voffA[i] = (unsigned)(R * K + C) * 2u; voffB[i] = (unsigned)(Rb * K + C) * 2u; }
    const size_t kstep = (size_t)(BK * 2);
    const size_t hstep = (size_t)HALF * K * 2;
    const size_t tstep = 2 * hstep;
    const unsigned ldsw = (unsigned)wid * 1024u; const unsigned lds0_ = (unsigned)__builtin_amdgcn_readfirstlane((int)((unsigned)(size_t)lds + (unsigned)wid * 1024u));
    const int aoff = lds_byte(wr * 64 + fr, fq * 8), boff = lds_byte(wc * 32 + fr, fq * 8);
#define PG8_SA(b, h) (((b) * 2 + (h)) * HTB)
#define PG8_SB(b, h) ((4 + (b) * 2 + (h)) * HTB)
#define PG8_STAGE(bufoff, gbase, voff) do { unsigned keep_; const unsigned d0_ = lds0_ + (unsigned)(bufoff), d1_ = d0_ + 8192u; \
        asm volatile("s_mov_b32 %0, m0\n\ts_mov_b32 m0, %3\n\ts_nop 0\n\tglobal_load_lds_dwordx4 %1, %5\n\ts_mov_b32 m0, %4\n\ts_nop 0\n\tglobal_load_lds_dwordx4 %2, %5\n\ts_mov_b32 m0, %0" \
                     : "=&s"(keep_) : "v"((voff)[0]), "v"((voff)[1]), "s"(d0_), "s"(d1_), "s"((const char*)(gbase)) : "memory"); } while (0)
#define PG8_LDA(dst, b, h) do { _Pragma("unroll") for (int m = 0; m < 4; ++m) _Pragma("unroll") for (int k = 0; k < 2; ++k) dst[m][k] = *(const PG8_LAS bf16x8*)(lds + PG8_SA(b, h) + aoff + m * 2048 + k * 1024); } while (0)
#define PG8_LDB(dst, b, h) do { _Pragma("unroll") for (int n = 0; n < 2; ++n) _Pragma("unroll") for (int k = 0; k < 2; ++k) dst[n][k] = *(const PG8_LAS bf16x8*)(lds + PG8_SB(b, h) + boff + n * 2048 + k * 1024); } while (0)
#define PG8_MMA(ai, bj, At, Bt) do { __builtin_amdgcn_s_setprio(1); _Pragma("unroll") for (int m = 0; m < 4; ++m) _Pragma("unroll") for (int n = 0; n < 2; ++n) _Pragma("unroll") for (int k = 0; k < 2; ++k) \
        acc[ai][bj][m][n] = __builtin_amdgcn_mfma_f32_16x16x32_bf16(Bt[n][k], At[m][k], acc[ai][bj][m][n], 0, 0, 0); __builtin_amdgcn_s_setprio(0); } while (0)
#define PG8_WAIT_V(n) asm volatile("s_waitcnt vmcnt(" #n ")" ::: "memory")
#define PG8_WAIT_L(n) asm volatile("s_waitcnt lgkmcnt(" #n ")" ::: "memory")
#define PG8_BAR __builtin_amdgcn_s_barrier()
#define PG8_SCHED __builtin_amdgcn_sched_barrier(0)
    unsigned long long tprev_ = 0, tloc_ = 0;
#define PG8_T0(k) do { if (PROBE_TK == (k) && Epi::TAG == PROBE_TAG && wid == PROBE_TW) { PG8_SCHED; tprev_ = __builtin_amdgcn_s_memrealtime(); PG8_SCHED; } } while (0)
#define PG8_T1(k) do { if (PROBE_TK == (k) && Epi::TAG == PROBE_TAG && wid == PROBE_TW) { PG8_SCHED; tloc_ += __builtin_amdgcn_s_memrealtime() - tprev_; PG8_SCHED; } } while (0)
    Unit cur, nxt; int ui = 0;
    if (!S.next(0, cur)) return;
    f32x4 acc[2][2][4][2];
#pragma unroll
    for (int a = 0; a < 2; ++a)
#pragma unroll
        for (int b = 0; b < 2; ++b)
#pragma unroll
            for (int m = 0; m < 4; ++m)
#pragma unroll
                for (int n = 0; n < 2; ++n) acc[a][b][m][n] = (f32x4){0.f, 0.f, 0.f, 0.f};
    bf16x8 At[4][2], B0[2][2], B1[2][2];
    const char* cA = (const char*)g.A + (size_t)cur.pm * tstep; const char* cB = (const char*)g.Bt + (size_t)cur.pn * tstep;
    S.a_ready(cur);
    if constexpr (SP2) {
        PG8_STAGE(PG8_SB(0, 0), cB, voffB); PG8_STAGE(PG8_SB(0, 1), cB + hstep, voffB); PG8_STAGE(PG8_SA(0, 0), cA, voffA); PG8_STAGE(PG8_SA(0, 1), cA + hstep, voffA);
        if (wr == 1) PG8_BAR;
        PG8_WAIT_V(2); PG8_BAR;
        PG8_STAGE(PG8_SB(1, 0), cB + kstep, voffB); PG8_STAGE(PG8_SA(1, 0), cA + kstep, voffA); PG8_STAGE(PG8_SB(1, 1), cB + hstep + kstep, voffB);
        PG8_WAIT_V(6); PG8_BAR;
    } else {
        PG8_STAGE(PG8_SB(0, 0), cB, voffB); PG8_STAGE(PG8_SA(0, 0), cA, voffA); PG8_STAGE(PG8_SB(0, 1), cB + hstep, voffB); PG8_STAGE(PG8_SA(0, 1), cA + hstep, voffA);
        if (wr == 1) PG8_BAR;
        PG8_WAIT_V(4); PG8_BAR;
        PG8_STAGE(PG8_SB(1, 0), cB + kstep, voffB); PG8_STAGE(PG8_SA(1, 0), cA + kstep, voffA); PG8_STAGE(PG8_SB(1, 1), cB + hstep + kstep, voffB);
        PG8_WAIT_V(6); PG8_BAR;
    }
    for (;;) {
        const bool has_next = S.next(ui + 1, nxt);
        const char* nA = has_next ? (const char*)g.A + (size_t)nxt.pm * tstep : cA; const char* nB = has_next ? (const char*)g.Bt + (size_t)nxt.pn * tstep : cB;
        for (int t = 0; t < nt; t += 2) {
            if constexpr (Epi::MIDK > 0) { if (t == Epi::MIDK) E.mid(acc, cur, wr, wc, fr, fq); }
            const bool last = (t == nt - 2);
            const char* a1 = cA + (size_t)(t + 1) * kstep;
            const char* a2 = last ? nA : cA + (size_t)(t + 2) * kstep; const char* b2 = last ? nB : cB + (size_t)(t + 2) * kstep;
            const char* a3 = a2 + kstep; const char* b3 = b2 + kstep;
            if (last && has_next) S.a_ready(nxt);
            if constexpr (SP2) {
            PG8_LDB(B0, 0, 0); PG8_LDB(B1, 0, 1); PG8_SCHED; PG8_LDA(At, 0, 0); PG8_STAGE(PG8_SA(1, 1), a1 + hstep, voffA);
            PG8_WAIT_V(8); PG8_WAIT_L(0); PG8_BAR; PG8_MMA(0, 0, At, B0); PG8_MMA(0, 1, At, B1); PG8_BAR; PG8_SCHED;
            PG8_LDA(At, 0, 1); PG8_STAGE(PG8_SB(0, 0), b2, voffB); PG8_STAGE(PG8_SB(0, 1), b2 + hstep, voffB); PG8_STAGE(PG8_SA(0, 0), a2, voffA);
            PG8_WAIT_V(8); PG8_WAIT_L(0); PG8_BAR; PG8_MMA(1, 0, At, B0); PG8_MMA(1, 1, At, B1); PG8_BAR; PG8_SCHED;
            PG8_LDB(B0, 1, 0); PG8_LDB(B1, 1, 1); PG8_SCHED; PG8_LDA(At, 1, 0); PG8_STAGE(PG8_SA(0, 1), a2 + hstep, voffA);
            PG8_WAIT_V(8); PG8_WAIT_L(0); PG8_BAR; PG8_MMA(0, 0, At, B0); PG8_MMA(0, 1, At, B1); PG8_BAR; PG8_SCHED;
            PG8_LDA(At, 1, 1); PG8_STAGE(PG8_SB(1, 0), b3, voffB); PG8_STAGE(PG8_SB(1, 1), b3 + hstep, voffB); PG8_STAGE(PG8_SA(1, 0), a3, voffA);
            PG8_WAIT_V(8); PG8_WAIT_L(0); PG8_BAR; PG8_MMA(1, 0, At, B0); PG8_MMA(1, 1, At, B1); PG8_BAR; PG8_SCHED;
            } else {
            PG8_LDB(B0, 0, 0); PG8_SCHED; PG8_LDA(At, 0, 0); PG8_STAGE(PG8_SA(1, 1), a1 + hstep, voffA);
            PG8_WAIT_L(8); PG8_BAR; PG8_WAIT_L(0); PG8_MMA(0, 0, At, B0); PG8_BAR; PG8_SCHED;
            PG8_LDB(B1, 0, 1); PG8_STAGE(PG8_SB(0, 0), b2, voffB);
            PG8_BAR; PG8_WAIT_L(0); PG8_MMA(0, 1, At, B1); PG8_BAR;
            PG8_LDA(At, 0, 1); PG8_STAGE(PG8_SA(0, 0), a2, voffA);
            PG8_BAR; PG8_WAIT_L(0); PG8_MMA(1, 0, At, B0); PG8_BAR; PG8_SCHED;
            PG8_STAGE(PG8_SB(0, 1), b2 + hstep, voffB);
            PG8_WAIT_V(6); PG8_BAR; PG8_MMA(1, 1, At, B1); PG8_BAR;
            PG8_LDB(B0, 1, 0); PG8_SCHED; PG8_LDA(At, 1, 0); PG8_STAGE(PG8_SA(0, 1), a2 + hstep, voffA);
            PG8_WAIT_L(8); PG8_BAR; PG8_WAIT_L(0); PG8_MMA(0, 0, At, B0); PG8_BAR; PG8_SCHED;
            PG8_LDB(B1, 1, 1); PG8_STAGE(PG8_SB(1, 0), b3, voffB);
            PG8_BAR; PG8_WAIT_L(0); PG8_MMA(0, 1, At, B1); PG8_BAR;
            PG8_LDA(At, 1, 1); PG8_STAGE(PG8_SA(1, 0), a3, voffA);
            PG8_BAR; PG8_WAIT_L(0); PG8_MMA(1, 0, At, B0); PG8_BAR; PG8_SCHED;
            PG8_STAGE(PG8_SB(1, 1), b3 + hstep, voffB);
            PG8_WAIT_V(6); PG8_BAR; PG8_MMA(1, 1, At, B1); PG8_BAR;
            }
        }
        if constexpr (ALIGN_EPI) { if (wr == 0) PG8_BAR; }
        PG8_T0(11);
        if constexpr (!Epi::AFTER_DRAIN) { E(acc, cur, wr, wc, fr, fq); S.done(cur); }
        PG8_T1(11);
        if (!has_next) break;
#pragma unroll
        for (int a = 0; a < 2; ++a)
#pragma unroll
            for (int b = 0; b < 2; ++b)
#pragma unroll
                for (int m = 0; m < 4; ++m)
#pragma unroll
                    for (int n = 0; n < 2; ++n) acc[a][b][m][n] = (f32x4){0.f, 0.f, 0.f, 0.f};
        cur = nxt; cA = nA; cB = nB; ++ui;
        if constexpr (ALIGN_EPI) { if (wr == 1) PG8_BAR; }
    }
    if (PROBE_TK >= 5 && PROBE_TK < 20 && Epi::TAG == PROBE_TAG && wid == PROBE_TW && lane == 0) { PG8_LAS unsigned* tw = (PG8_LAS unsigned*)(lds + 163840 - 128); *tw += (unsigned)tloc_; }
    PG8_WAIT_V(0);
    if constexpr (!ALIGN_EPI) { if (wr == 0) PG8_BAR; }
    PG8_BAR;
    if constexpr (Epi::AFTER_DRAIN) { E.fused(acc, cur, wr, wc, fr, fq, lds, wid, lane); S.done(cur); }
#undef PG8_SA
#undef PG8_SB
#undef PG8_STAGE
#undef PG8_LDA
#undef PG8_LDB
#undef PG8_MMA
#undef PG8_WAIT_V
#undef PG8_WAIT_L
#undef PG8_BAR
#undef PG8_SCHED
#undef PG8_T0
#undef PG8_T1
}
}
#define GAS __attribute__((address_space(1)))
#define LAS __attribute__((address_space(3)))
typedef unsigned short bf16;
typedef unsigned v4u __attribute__((ext_vector_type(4)));
typedef float f32x4 __attribute__((ext_vector_type(4)));
typedef short bf16x8 __attribute__((ext_vector_type(8)));
typedef GAS unsigned gu32;
typedef GAS unsigned long long gu64;
#define RLX_AGENT __ATOMIC_RELAXED, __HIP_MEMORY_SCOPE_AGENT
#define LDS_WAIT() asm volatile("s_waitcnt lgkmcnt(0)" ::: "memory")
#define VM_WAIT() asm volatile("s_waitcnt vmcnt(0)" ::: "memory")
__device__ __forceinline__ unsigned long long rt() { return __builtin_amdgcn_s_memrealtime(); }
__device__ __forceinline__ unsigned f2bf(float f) { unsigned u = __builtin_bit_cast(unsigned, f); return (u + 0x7fffu + ((u >> 16) & 1u)) >> 16; }
__device__ __forceinline__ unsigned pk2(float lo, float hi) { return f2bf(lo) | (f2bf(hi) << 16); }

#define XB_TMO      128
#define XB_XCNT(j)  (256  + 64 * (j))
#define XB_XSUB(j)  (1280 + 64 * (j))
#define XB_XGEN(j)  (2304 + 64 * (j))
#define XB_TOP      3328
#define XB_TOPGEN   3392
#define XCD_BAR_WORDS 3456
#define XB_SPIN_CAP (1u << 18)

__device__ __forceinline__ unsigned xb_ld(unsigned* p)              { return __hip_atomic_load(p, __ATOMIC_RELAXED, __HIP_MEMORY_SCOPE_AGENT); }
__device__ __forceinline__ unsigned xb_add(unsigned* p, unsigned v) { return __hip_atomic_fetch_add(p, v, __ATOMIC_RELAXED, __HIP_MEMORY_SCOPE_AGENT); }
__device__ __forceinline__ unsigned xb_xcc_id() { return (unsigned)__builtin_amdgcn_s_getreg((3 << 11) | 20) & 0xFu; }
#define XB_SPIN(cond, bar) do { unsigned _sp = 0; while (cond) { __builtin_amdgcn_s_sleep(1); \
    if ((++_sp & 255u) == 0u) { if (xb_ld(&(bar)[XB_TMO])) break; if (_sp > XB_SPIN_CAP) { atomicAdd(&(bar)[XB_TMO], 1u); break; } } } } while (0)

struct XcdBarrier {
    unsigned* bar; unsigned x;
    volatile LAS unsigned* st;
};

__device__ __forceinline__ XcdBarrier xcd_barrier_post(unsigned* bar, volatile LAS unsigned* st) {
    XcdBarrier b; b.bar = bar; b.x = xb_xcc_id(); b.st = st;
    if (threadIdx.x == 0) (void)xb_add(&bar[XB_XCNT(b.x)], 1u);
    return b;
}
__device__ __forceinline__ void xcd_barrier_complete(unsigned* bar, unsigned x, unsigned& nloc, unsigned& nx) {
    const unsigned G = gridDim.x * gridDim.y * gridDim.z;
    unsigned sum, cnt, mine, sp = 0u;
    for (;;) {
        sum = 0u; cnt = 0u; mine = 0u;
#pragma unroll
        for (unsigned j = 0; j < 16; ++j) { const unsigned c = xb_ld(&bar[XB_XCNT(j)]); sum += c; cnt += (c > 0u) ? 1u : 0u; mine = (j == x) ? c : mine; }
        if (sum == G) break;
        __builtin_amdgcn_s_sleep(1);
        if ((++sp & 255u) == 0u) { if (xb_ld(&bar[XB_TMO])) break; if (sp > XB_SPIN_CAP) { atomicAdd(&bar[XB_TMO], 1u); break; } }
    }
    nloc = mine > 0u ? mine : 1u; nx = cnt > 0u ? cnt : 1u;
}

__device__ __forceinline__ void xcd_barrier(const XcdBarrier& b) {
    asm volatile("s_waitcnt vmcnt(0)" ::: "memory");
    __syncthreads();
    if (threadIdx.x == 0) {
        unsigned* bar = b.bar;
        __builtin_amdgcn_s_waitcnt(0);
        unsigned nloc = b.st[0], nx = b.st[1];
        if (nloc == 0u) { xcd_barrier_complete(bar, b.x, nloc, nx); b.st[0] = nloc; b.st[1] = nx; }
        const unsigned old = xb_add(&bar[XB_XSUB(b.x)], 1u);
        const unsigned gen = old / nloc;
        if (old + 1u == (gen + 1u) * nloc) {
            __builtin_amdgcn_fence(__ATOMIC_RELEASE, "agent");
            asm volatile("s_waitcnt vmcnt(0)" ::: "memory");
            const unsigned og = xb_add(&bar[XB_TOP], 1u);
            const unsigned tg = og / nx;
            if (og + 1u == (tg + 1u) * nx) xb_add(&bar[XB_TOPGEN], 1u);
            else XB_SPIN(xb_ld(&bar[XB_TOPGEN]) == tg, bar);
            __builtin_amdgcn_fence(__ATOMIC_ACQUIRE, "agent");
            xb_add(&bar[XB_XGEN(b.x)], 1u);
            asm volatile("s_waitcnt vmcnt(0)" ::: "memory");
        } else {
            XB_SPIN(xb_ld(&bar[XB_XGEN(b.x)]) == gen, bar);
            __builtin_amdgcn_fence(__ATOMIC_ACQUIRE, "agent");
            asm volatile("s_waitcnt vmcnt(0)" ::: "memory");
        }
    }
    __syncthreads();
}

constexpr int NWAVES = 8;
constexpr int BATCH = 8, SEQ = 4096, DM = 1024, M = BATCH * SEQ, INW = 6656, FF = 4096;
constexpr int NFREQ = 72;
constexpr float C2 = 0.125f * 1.4426950408889634f;
constexpr float KR_SCALE = 0.08838834764831845f;
constexpr float LAMBDA_INIT = 0.2f;
constexpr int N_PHASES = 8;
#define PROBE_CLK -1
#define PROBE_CLK_E -1
#define PROBE_CLK_DUR 0
#ifndef PROBE_XCC
#define PROBE_XCC 0
#endif
#ifndef PROBE_STAGGER
#define PROBE_STAGGER 0
#endif
#ifndef PROBE_ST2
#define PROBE_ST2 0
#endif
#ifndef MK_N_LAUNCHES
#define MK_N_LAUNCHES 1
#endif

constexpr size_t MiB = 1u << 20;
constexpr size_t WS_CTL = 0, CTL_ZERO_BYTES = 64 * 1024;
constexpr size_t WS_WIN = 2 * MiB, WS_WA = 15 * MiB, WS_WR = 16 * MiB, WS_WO = 18 * MiB, WS_W1 = 20 * MiB, WS_W2 = 28 * MiB;
constexpr size_t WS_CS = 36 * MiB;
constexpr size_t WS_RSS = 54 * MiB;
constexpr size_t WS_MISC = 56 * MiB;
constexpr size_t WS_XN = 64 * MiB;
constexpr size_t WS_QD = 128 * MiB, WS_KD = 160 * MiB, WS_VD = 192 * MiB, WS_QR = 224 * MiB, WS_KR = 256 * MiB;
constexpr size_t WS_VR = 288 * MiB, WS_GS = 352 * MiB;
constexpr size_t WS_OA = 416 * MiB;
constexpr size_t WS_ORR = 448 * MiB;
constexpr size_t WS_TMP = 128 * MiB, WS_MRG = 192 * MiB;
constexpr size_t WS_HID = 128 * MiB;
constexpr size_t WS_ORAW = WS_XN;
constexpr size_t WS_KV = WS_XN;
constexpr size_t WS_ST = WS_QD;
constexpr size_t WS_END = 512 * MiB;
constexpr int CW_BAR = 4096;

constexpr int RING_BYTES = 131072;
constexpr int LDS_BYTES = 163840;
constexpr int MISC_OFF = LDS_BYTES - 256;

struct Frame {
    LAS unsigned char* lds;
    volatile LAS unsigned* MISC;
    gu32* ctl;
    int tid, lane, wave, G;
    unsigned char* ws;
    unsigned long long tacc;
};
struct Args { const void* in[18]; float* out; unsigned char* ws; double invf[NFREQ]; float lg2[4]; int ph_lo, ph_hi, li, pad; };

__device__ __forceinline__ float wave_sum(float v) {
#pragma unroll
    for (int o = 1; o < 64; o <<= 1) v += __shfl_xor(v, o);
    return v;
}
__device__ __forceinline__ float bf2f(unsigned short h) { return __builtin_bit_cast(float, (unsigned)h << 16); }
__device__ __forceinline__ float bflo(unsigned w) { return __builtin_bit_cast(float, w << 16); }
__device__ __forceinline__ float bfhi(unsigned w) { return __builtin_bit_cast(float, w & 0xffff0000u); }

__host__ __device__ __forceinline__ int da_dim(int bj, int i, int fq) {
    if (bj == 0 && i < 4) return (i & 1) + 2 * fq + 8 * (i >> 1);
    const int idx = bj == 0 ? i - 4 : 4 + i; return 16 + 12 * fq + idx;
}
__host__ __device__ __forceinline__ int win_col(int p) {
    const int pn = p >> 8, t = p & 255, bj = t >> 7, wc = (t >> 5) & 3, fq = (t >> 3) & 3, i = t & 7;
    if (pn < 4) { const int G = 4 * (pn & 1) + wc; return (pn >> 1) * 512 + 64 * G + da_dim(bj, i, fq); }
    if (pn >= 6 && pn < 10) { const int head = 2 * (pn & 1) + (wc >> 1); return 1536 + ((pn - 6) >> 1) * 512 + 128 * head + 64 * bj + 32 * (wc & 1) + 8 * fq + i; }
    if (pn >= 18) return 4608 + bj * 1024 + 128 * (pn - 18) + (t & 127);
    return p;
}

template <bool PERMUTE>
__device__ __forceinline__ void p0_transpose_item(const float* W, int K, int N, bf16* WT, LAS float* scr, int item, int lane, const float* kscale, int ldk = 0, int koff = 0) {
    if (ldk == 0) ldk = K;
    const int nblk = N / 32, kb = item / nblk, nb = item % nblk, k0 = 64 * kb, n0 = 32 * nb;
    const int col = PERMUTE ? win_col(n0 + (lane & 31)) : n0 + (lane & 31);
    if constexpr (PERMUTE) {
        float v[32];
#pragma unroll
        for (int i = 0; i < 32; ++i) v[i] = __builtin_nontemporal_load((const GAS float*)W + (size_t)(k0 + 2 * i + (lane >> 5)) * N + col);
#pragma unroll
        for (int i = 0; i < 32; ++i) { const int kk = 2 * i + (lane >> 5); scr[kk * 33 + (lane & 31)] = kscale ? v[i] * kscale[k0 + kk] : v[i]; }
    } else {
        f32x4 v[8];
#pragma unroll
        for (int i = 0; i < 8; ++i) v[i] = __builtin_nontemporal_load((const GAS f32x4*)(W + (size_t)(k0 + 8 * i + (lane >> 3)) * N + n0 + 4 * (lane & 7)));
#pragma unroll
        for (int i = 0; i < 8; ++i) { const int kk = 8 * i + (lane >> 3); const float ks = kscale ? kscale[k0 + kk] : 1.0f; LAS float* d = scr + kk * 33 + 4 * (lane & 7);
            d[0] = v[i][0] * ks; d[1] = v[i][1] * ks; d[2] = v[i][2] * ks; d[3] = v[i][3] * ks; }
    }
    LDS_WAIT(); asm volatile("" ::: "memory");
    const int c = lane & 7;
#pragma unroll
    for (int j = 0; j < 4; ++j) { const int n = (lane >> 3) + 8 * j; const LAS float* s = scr + (8 * c) * 33 + n;
        v4u o; o.x = pk2(s[0 * 33], s[1 * 33]); o.y = pk2(s[2 * 33], s[3 * 33]); o.z = pk2(s[4 * 33], s[5 * 33]); o.w = pk2(s[6 * 33], s[7 * 33]);
        *(GAS v4u*)(WT + (size_t)(n0 + n) * ldk + koff + k0 + 8 * c) = o; }
    LDS_WAIT(); asm volatile("" ::: "memory");
}
__device__ __forceinline__ void p0_prologue(Frame& F, const Args& A, int parts = 3) {
    const float* x = (const float*)A.in[0]; const float* n1w = (const float*)A.in[2];
    LAS float* scr = (LAS float*)(F.lds + F.wave * 16384);
    const int gw = blockIdx.x * NWAVES + F.wave, NGW = F.G * NWAVES;
    constexpr int I_IN = (DM / 64) * (INW / 32), I_A = (512 / 64) * (DM / 32), I_R = (DM / 64) * (DM / 32), I_O = I_R, I_1 = (DM / 64) * (FF / 32), I_2 = (FF / 64) * (DM / 32);
    constexpr int NITEMS = I_IN + I_A + I_R + I_O + I_1 + I_2;
    if (parts & 1) for (int it = gw; it < NITEMS; it += NGW) {
        int r = it;
        if (r < I_IN) { p0_transpose_item<true>((const float*)A.in[3], DM, INW, (bf16*)(F.ws + WS_WIN), scr, r, F.lane, nullptr); continue; } r -= I_IN;
        if (r < I_A) { p0_transpose_item<false>((const float*)A.in[11], 512, DM, (bf16*)(F.ws + WS_WA), scr, r, F.lane, nullptr, 1536, 0); continue; } r -= I_A;
        if (r < I_R) { p0_transpose_item<false>((const float*)A.in[13], DM, DM, (bf16*)(F.ws + WS_WA), scr, r, F.lane, nullptr, 1536, 512); continue; } r -= I_R;
        if (r < I_O) { p0_transpose_item<false>((const float*)A.in[14], DM, DM, (bf16*)(F.ws + WS_WO), scr, r, F.lane, nullptr); continue; } r -= I_O;
        if (r < I_1) { p0_transpose_item<false>((const float*)A.in[16], DM, FF, (bf16*)(F.ws + WS_W1), scr, r, F.lane, (const float*)A.in[15]); continue; } r -= I_1;
        p0_transpose_item<false>((const float*)A.in[17], FF, DM, (bf16*)(F.ws + WS_W2), scr, r, F.lane, nullptr);
    }
    bf16* XN = (bf16*)(F.ws + WS_XN);
    f32x4 wv[4];
#pragma unroll
    for (int j = 0; j < 4; ++j) wv[j] = ((const GAS f32x4*)n1w)[128 * (j >> 1) + 2 * F.lane + (j & 1)];
    if (parts & 2) for (int m0 = gw; m0 < M; m0 += 4 * NGW) {
        f32x4 v[4][4];
#pragma unroll
        for (int r = 0; r < 4; ++r) { const int m = m0 + r * NGW < M ? m0 + r * NGW : m0; const GAS f32x4* xr = (const GAS f32x4*)(x + (size_t)m * DM) + 2 * F.lane;
#pragma unroll
            for (int j = 0; j < 2; ++j) { v[r][2 * j] = __builtin_nontemporal_load(xr + 128 * j); v[r][2 * j + 1] = __builtin_nontemporal_load(xr + 128 * j + 1); } }
#pragma unroll
        for (int r = 0; r < 4; ++r) { const int m = m0 + r * NGW; float s = 0.f;
#pragma unroll
            for (int j = 0; j < 4; ++j) s += (v[r][j].x * v[r][j].x + v[r][j].y * v[r][j].y) + (v[r][j].z * v[r][j].z + v[r][j].w * v[r][j].w);
            const float rstd = 1.f / sqrtf(wave_sum(s) * (1.f / DM) + 1e-6f);
            if (m < M) { GAS v4u* o16 = (GAS v4u*)(XN + (size_t)m * DM) + F.lane;
#pragma unroll
                for (int j = 0; j < 2; ++j) { const f32x4 a = v[r][2 * j], b = v[r][2 * j + 1], wa = wv[2 * j], wb = wv[2 * j + 1]; v4u o;
                    o.x = pk2(a.x * rstd * wa.x, a.y * rstd * wa.y); o.y = pk2(a.z * rstd * wa.z, a.w * rstd * wa.w); o.z = pk2(b.x * rstd * wb.x, b.y * rstd * wb.y); o.w = pk2(b.z * rstd * wb.z, b.w * rstd * wb.w);
                    o16[64 * j] = o; } } }
    }
    if (blockIdx.x == 0 && F.wave == 0) {
        const float* qn = (const float*)A.in[4]; const float* kn = (const float*)A.in[5];
        const float* l1q = (const float*)A.in[6]; const float* l1k = (const float*)A.in[7]; const float* l2q = (const float*)A.in[8]; const float* l2k = (const float*)A.in[9];
        const float s1 = wave_sum(l1q[F.lane] * l1k[F.lane]), s2 = wave_sum(l2q[F.lane] * l2k[F.lane]);
        float mq = fabsf(qn[F.lane]), mk = fabsf(kn[F.lane]);
#pragma unroll
        for (int o = 1; o < 64; o <<= 1) { mq = fmaxf(mq, __shfl_xor(mq, o)); mk = fmaxf(mk, __shfl_xor(mk, o)); }
        if (F.lane == 0) { GAS float* misc = (GAS float*)(F.ws + WS_MISC); misc[0] = expf(s1) - expf(s2) + LAMBDA_INIT; misc[1] = 8.0f * 1.4426950408889634f * mq * mk * 1.01f; }
    }
}

using pg8::bf16_t; using pg8::Unit; using pg8::cvt_pk_bf16;
typedef unsigned u32x4e __attribute__((ext_vector_type(4)));
__device__ __forceinline__ u32x4e pack8(const f32x4& a, const f32x4& b) { u32x4e w; w.x = cvt_pk_bf16(a[0], a[1]); w.y = cvt_pk_bf16(a[2], a[3]); w.z = cvt_pk_bf16(b[0], b[1]); w.w = cvt_pk_bf16(b[2], b[3]); return w; }
__device__ __forceinline__ float sigmoidf_(float v) { return __builtin_amdgcn_rcpf(1.0f + __builtin_amdgcn_exp2f(-1.4426950408889634f * v)); }

struct EpiProj {
    static constexpr bool PERM = true, AFTER_DRAIN = false; static constexpr int MIDK = 0; static constexpr int TAG = 1;
    bf16_t *QD, *KD, *QR, *KR, *GATE; unsigned char* ws; const int* pos; const float* qnw; const float* knw; float lg0, lg1, lg2, lg3;
    __device__ __forceinline__ void operator()(const f32x4 (&acc)[2][2][4][2], const Unit& u, int wr, int wc, int fr_, int fq_) const {
        int fr = fr_, fq = fq_; asm volatile("" : "+v"(fr), "+v"(fq));
        const int pn = u.pn, row0 = u.pm * 256 + wr * 64 + fr;
        if (pn < 4) {
            const bool isq = pn < 2; const float* nw = isq ? qnw : knw; bf16_t* dst = (isq ? QD : KD) + 64 * (4 * (pn & 1) + wc) + 8 * fq;
            const float osc = isq ? C2 : 1.0f;
            float w[2][8];
#pragma unroll
            for (int bj = 0; bj < 2; ++bj)
#pragma unroll
                for (int i = 0; i < 8; ++i) w[bj][i] = ((const GAS float*)nw)[da_dim(bj, i, fq)] * osc;
            const float rda0 = __builtin_amdgcn_exp2f(-(float)(2 * fq) * (18.931568569324174f / 8.0f)) * 0.15915494309189535f, rda1 = __builtin_amdgcn_exp2f(-(float)(2 * fq + 1) * (18.931568569324174f / 8.0f)) * 0.15915494309189535f;
            int pq[2][4];
#pragma unroll
            for (int ai = 0; ai < 2; ++ai)
#pragma unroll
                for (int m = 0; m < 4; ++m) pq[ai][m] = ((const GAS int*)pos)[row0 + ai * 128 + m * 16];
#pragma unroll
            for (int ai = 0; ai < 2; ++ai)
#pragma unroll
                for (int m = 0; m < 4; ++m) {
                    const int row = row0 + ai * 128 + m * 16;
                    f32x4 a0 = acc[ai][0][m][0], a1 = acc[ai][0][m][1], b0 = acc[ai][1][m][0], b1 = acc[ai][1][m][1];
                    float ss = (a0[0] * a0[0] + a0[1] * a0[1]) + (a0[2] * a0[2] + a0[3] * a0[3]) + (a1[0] * a1[0] + a1[1] * a1[1]) + (a1[2] * a1[2] + a1[3] * a1[3])
                             + (b0[0] * b0[0] + b0[1] * b0[1]) + (b0[2] * b0[2] + b0[3] * b0[3]) + (b1[0] * b1[0] + b1[1] * b1[1]) + (b1[2] * b1[2] + b1[3] * b1[3]);
                    ss += __shfl_xor(ss, 16); ss += __shfl_xor(ss, 32);
                    const float rs = __builtin_amdgcn_rsqf(ss * (1.0f / 64.0f) + 1e-6f);
#pragma unroll
                    for (int e = 0; e < 4; ++e) { a0[e] *= rs * w[0][e]; a1[e] *= rs * w[0][4 + e]; b0[e] *= rs * w[1][e]; b1[e] *= rs * w[1][4 + e]; }
                    const float pf = (float)pq[ai][m];
                    const float v0_ = __builtin_amdgcn_fractf(pf * rda0), v1_ = __builtin_amdgcn_fractf(pf * rda1);
                    const float c0 = __builtin_amdgcn_cosf(v0_), s0 = __builtin_amdgcn_sinf(v0_), c1 = __builtin_amdgcn_cosf(v1_), s1 = __builtin_amdgcn_sinf(v1_);
                    { const float t1 = a0[0], t2 = a0[2]; a0[0] = t1 * c0 - t2 * s0; a0[2] = t1 * s0 + t2 * c0; }
                    { const float t1 = a0[1], t2 = a0[3]; a0[1] = t1 * c1 - t2 * s1; a0[3] = t1 * s1 + t2 * c1; }
                    bf16_t* rp = dst + (size_t)row * 512;
                    *(GAS u32x4e*)(rp) = pack8(a0, a1); *(GAS u32x4e*)(rp + 32) = pack8(b0, b1);
                    asm volatile("" ::: "memory");
                }
        } else if (pn >= 6 && pn < 10) {
            const bool isq = pn < 8; const int j0 = 32 * (wc & 1) + 8 * fq;
            bf16_t* dst = (isq ? QR : KR) + 128 * (2 * (pn & 1) + (wc >> 1)) + j0;
            const int head = 2 * (pn & 1) + (wc >> 1); const float lgh = head == 0 ? lg0 : (head == 1 ? lg1 : (head == 2 ? lg2 : lg3));
            const float osc0 = isq ? 1.0f : KR_SCALE, lgs = isq ? lgh : -lgh;
            float rrt[8];
#pragma unroll
            for (int i = 0; i < 8; ++i) rrt[i] = __builtin_amdgcn_exp2f(-(float)(j0 + i) * (13.287712379549449f / 63.0f)) * 0.15915494309189535f;
            int pq[2][4];
#pragma unroll
            for (int ai = 0; ai < 2; ++ai)
#pragma unroll
                for (int m = 0; m < 4; ++m) pq[ai][m] = ((const GAS int*)pos)[row0 + ai * 128 + m * 16];
#pragma unroll
            for (int ai = 0; ai < 2; ++ai)
#pragma unroll
                for (int m = 0; m < 4; ++m) {
                    const int row = row0 + ai * 128 + m * 16;
                    const float pf = (float)pq[ai][m];
                    const float osc = osc0 * __builtin_amdgcn_exp2f(lgs * (float)(row & 127));
                    f32x4 t1[2] = {acc[ai][0][m][0], acc[ai][0][m][1]}, t2[2] = {acc[ai][1][m][0], acc[ai][1][m][1]}, o1[2], o2[2];
#pragma unroll
                    for (int n = 0; n < 2; ++n)
#pragma unroll
                        for (int e = 0; e < 4; ++e) { const float rv = __builtin_amdgcn_fractf(pf * rrt[4 * n + e]); const float cc = __builtin_amdgcn_cosf(rv) * osc, ss = __builtin_amdgcn_sinf(rv) * osc;
                            o1[n][e] = t1[n][e] * cc - t2[n][e] * ss; o2[n][e] = t1[n][e] * ss + t2[n][e] * cc; }
                    bf16_t* rp = dst + (size_t)row * 512;
                    *(GAS u32x4e*)(rp) = pack8(o1[0], o1[1]); *(GAS u32x4e*)(rp + 64) = pack8(o2[0], o2[1]);
                    asm volatile("" ::: "memory");
                }
        } else if (pn >= 18) {
            bf16_t* dst = GATE + 128 * (pn - 18) + wc * 32 + 8 * fq;
#pragma unroll
            for (int ai = 0; ai < 2; ++ai)
#pragma unroll
                for (int m = 0; m < 4; ++m) {
                    const int row = row0 + ai * 128 + m * 16; bf16_t* rp = dst + (size_t)row * 2048;
                    f32x4 g0 = acc[ai][0][m][0], g1 = acc[ai][0][m][1], r0 = acc[ai][1][m][0], r1 = acc[ai][1][m][1];
#pragma unroll
                    for (int e = 0; e < 4; ++e) {
                        const float ea = __builtin_amdgcn_exp2f(-1.4426950408889634f * fmaxf(r0[e], -30.0f)), eb = __builtin_amdgcn_exp2f(-1.4426950408889634f * fmaxf(r1[e], -30.0f));
                        g0[e] = sigmoidf_(g0[e]) * (1.0f + ea); g1[e] = sigmoidf_(g1[e]) * (1.0f + eb);
                        r0[e] = __builtin_amdgcn_rcpf(1.0f + ea); r1[e] = __builtin_amdgcn_rcpf(1.0f + eb); }
                    *(GAS u32x4e*)(rp) = pack8(g0, g1); *(GAS u32x4e*)(rp + 1024) = pack8(r0, r1);
                    asm volatile("" ::: "memory");
                }
        } else {
            const int act = pn < 14 ? 0 : (pn < 18 ? 1 : 2);
            const int ld = pn < 6 ? 512 : (pn < 18 ? 1024 : 2048);
            const int colt = (pn < 6 ? pn - 4 : (pn < 14 ? pn - 10 : (pn < 18 ? pn - 14 : pn - 18))) * 256;
            const size_t woff = pn < 6 ? WS_VD : (pn < 14 ? WS_VR : WS_GS);
            bf16_t* dst = (pn < 18 ? (bf16_t*)(ws + woff) : GATE) + colt + wc * 32 + 8 * fq;
#pragma unroll
            for (int ai = 0; ai < 2; ++ai)
#pragma unroll
                for (int m = 0; m < 4; ++m) {
                    const int row = row0 + ai * 128 + m * 16; bf16_t* rp = dst + (size_t)row * ld;
#pragma unroll
                    for (int bj = 0; bj < 2; ++bj) { f32x4 v0 = acc[ai][bj][m][0], v1 = acc[ai][bj][m][1];
                        if (act) {
#pragma unroll
                            for (int e = 0; e < 4; ++e) { const float s0 = sigmoidf_(v0[e]), s1 = sigmoidf_(v1[e]); v0[e] = act == 1 ? v0[e] * s0 : s0; v1[e] = act == 1 ? v1[e] * s1 : s1; } }
                        *(GAS u32x4e*)(rp + bj * 128) = pack8(v0, v1); }
                    asm volatile("" ::: "memory");
                }
        }
    }
};
struct EpiMerge2 {
    static constexpr bool PERM = true, AFTER_DRAIN = false; static constexpr int MIDK = 8; static constexpr int TAG = 5;
    const bf16_t* GATE; bf16_t* MRG;
    template <int HALF> __device__ __forceinline__ void scale(f32x4 (&acc)[2][2][4][2], const Unit& u, int wr, int wc, int fr_, int fq_) const {
        int fr = fr_, fq = fq_; asm volatile("" : "+v"(fr), "+v"(fq));
        const int row0 = u.pm * 256 + wr * 64 + fr, col0 = u.pn * 256 + wc * 32 + 8 * fq;
        u32x4e gq[2][4][2];
#pragma unroll
        for (int ai = 0; ai < 2; ++ai)
#pragma unroll
            for (int m = 0; m < 4; ++m)
#pragma unroll
                for (int bj = 0; bj < 2; ++bj) gq[ai][m][bj] = *(const GAS u32x4e*)(GATE + (size_t)(row0 + ai * 128 + m * 16) * 2048 + HALF * 1024 + col0 + bj * 128);
#pragma unroll
        for (int ai = 0; ai < 2; ++ai)
#pragma unroll
            for (int m = 0; m < 4; ++m) { const size_t row = (size_t)(row0 + ai * 128 + m * 16);
#pragma unroll
                for (int bj = 0; bj < 2; ++bj) { const int col = col0 + bj * 128;
                    const u32x4e g = gq[ai][m][bj];
                    f32x4& v0 = acc[ai][bj][m][0]; f32x4& v1 = acc[ai][bj][m][1];
                    v0[0] *= bflo(g.x); v0[1] *= bfhi(g.x); v0[2] *= bflo(g.y); v0[3] *= bfhi(g.y); v1[0] *= bflo(g.z); v1[1] *= bfhi(g.z); v1[2] *= bflo(g.w); v1[3] *= bfhi(g.w);
                    if (HALF == 1) *(GAS u32x4e*)(MRG + row * 1024 + col) = pack8(v0, v1); } }
    }
    __device__ __forceinline__ void mid(f32x4 (&acc)[2][2][4][2], const Unit& u, int wr, int wc, int fr, int fq) const { scale<0>(acc, u, wr, wc, fr, fq); }
    __device__ __forceinline__ void operator()(const f32x4 (&acc)[2][2][4][2], const Unit& u, int wr, int wc, int fr, int fq) const {
        f32x4 (&a)[2][2][4][2] = const_cast<f32x4 (&)[2][2][4][2]>(acc); scale<1>(a, u, wr, wc, fr, fq); }
};
struct EpiX1 {
    static constexpr bool PERM = true, AFTER_DRAIN = false; static constexpr int MIDK = 0; static constexpr int TAG = 6;
    const float* x; float* out; bf16_t* XN; float* rss;
    __device__ __forceinline__ void operator()(const f32x4 (&acc)[2][2][4][2], const Unit& u, int wr, int wc, int fr_, int fq_) const {
        int fr = fr_, fq = fq_; asm volatile("" : "+v"(fr), "+v"(fq));
        const int row0 = u.pm * 256 + wr * 64 + fr, col0 = u.pn * 256 + wc * 32 + 8 * fq;
#pragma unroll
        for (int ai = 0; ai < 2; ++ai) {
            f32x4 xq[4][2][2];
#pragma unroll
            for (int m = 0; m < 4; ++m)
#pragma unroll
                for (int bj = 0; bj < 2; ++bj) { const size_t off = (size_t)(row0 + ai * 128 + m * 16) * 1024 + col0 + bj * 128; xq[m][bj][0] = *(const GAS f32x4*)(x + off); xq[m][bj][1] = *(const GAS f32x4*)(x + off + 4); }
#pragma unroll
            for (int m = 0; m < 4; ++m) { const size_t row = (size_t)(row0 + ai * 128 + m * 16); float ss = 0.f;
#pragma unroll
                for (int bj = 0; bj < 2; ++bj) { const size_t off = row * 1024 + col0 + bj * 128;
                    const f32x4 v0 = acc[ai][bj][m][0] + xq[m][bj][0], v1 = acc[ai][bj][m][1] + xq[m][bj][1];
                    *(GAS u32x4e*)(XN + off) = pack8(v0, v1);
                    ss += (v0[0] * v0[0] + v0[1] * v0[1]) + (v0[2] * v0[2] + v0[3] * v0[3]) + (v1[0] * v1[0] + v1[1] * v1[1]) + (v1[2] * v1[2] + v1[3] * v1[3]); }
                ss += __shfl_xor(ss, 16); ss += __shfl_xor(ss, 32);
                if (fq == 0) ((GAS float*)rss)[row * 16 + u.pn * 4 + wc] = ss; }
        }
    }
};
struct EpiHid {
    static constexpr bool PERM = true, AFTER_DRAIN = false; static constexpr int MIDK = 0; static constexpr int TAG = 7;
    const float* rss; bf16_t* HID;
    __device__ __forceinline__ void operator()(const f32x4 (&acc)[2][2][4][2], const Unit& u, int wr, int wc, int fr_, int fq_) const {
        int fr = fr_, fq = fq_; asm volatile("" : "+v"(fr), "+v"(fq));
        const int row0 = u.pm * 256 + wr * 64 + fr, col0 = u.pn * 256 + wc * 32 + 8 * fq;
        f32x4 rq[2][4];
#pragma unroll
        for (int ai = 0; ai < 2; ++ai)
#pragma unroll
            for (int m = 0; m < 4; ++m) rq[ai][m] = *((const GAS f32x4*)(rss + (size_t)(row0 + ai * 128 + m * 16) * 16) + fq);
#pragma unroll
        for (int ai = 0; ai < 2; ++ai)
#pragma unroll
            for (int m = 0; m < 4; ++m) { const size_t row = (size_t)(row0 + ai * 128 + m * 16);
                const f32x4 r0 = rq[ai][m];
                float ssum = (r0[0] + r0[1]) + (r0[2] + r0[3]); ssum += __shfl_xor(ssum, 16); ssum += __shfl_xor(ssum, 32);
                const float rs = __builtin_amdgcn_rsqf(ssum * (1.0f / 1024.0f) + 1e-6f);
#pragma unroll
                for (int bj = 0; bj < 2; ++bj) { f32x4 v0 = acc[ai][bj][m][0] * rs, v1 = acc[ai][bj][m][1] * rs;
#pragma unroll
                    for (int e = 0; e < 4; ++e) { const float a = fmaxf(v0[e], 0.f), b = fmaxf(v1[e], 0.f); v0[e] = a * a; v1[e] = b * b; }
                    *(GAS u32x4e*)(HID + row * 4096 + col0 + bj * 128) = pack8(v0, v1); } }
    }
};
struct RevOrder : pg8::StaticOrder {
    __device__ __forceinline__ bool next(int i, pg8::Unit& u) const { const bool ok = pg8::StaticOrder::next(i, u); u.pm = nM - 1 - u.pm; return ok; }
};
struct EpiOut {
    static constexpr bool PERM = true, AFTER_DRAIN = false; static constexpr int MIDK = 0; static constexpr int TAG = 8;
    float* out; const bf16_t* XN;
    __device__ __forceinline__ void operator()(const f32x4 (&acc)[2][2][4][2], const Unit& u, int wr, int wc, int fr_, int fq_) const {
        int fr = fr_, fq = fq_; asm volatile("" : "+v"(fr), "+v"(fq));
        const int row0 = u.pm * 256 + wr * 64 + fr, col0 = u.pn * 256 + wc * 32 + 8 * fq;
        u32x4e xq[2][4][2];
#pragma unroll
        for (int ai = 0; ai < 2; ++ai)
#pragma unroll
            for (int m = 0; m < 4; ++m)
#pragma unroll
                for (int bj = 0; bj < 2; ++bj) xq[ai][m][bj] = *(const GAS u32x4e*)(XN + (size_t)(row0 + ai * 128 + m * 16) * 1024 + col0 + bj * 128);
#pragma unroll
        for (int ai = 0; ai < 2; ++ai)
#pragma unroll
            for (int m = 0; m < 4; ++m) { const size_t row = (size_t)(row0 + ai * 128 + m * 16);
#pragma unroll
                for (int bj = 0; bj < 2; ++bj) { float* p = out + row * 1024 + col0 + bj * 128; const u32x4e xr = xq[ai][m][bj];
                    f32x4 v0 = acc[ai][bj][m][0], v1 = acc[ai][bj][m][1];
                    v0[0] += bflo(xr.x); v0[1] += bfhi(xr.x); v0[2] += bflo(xr.y); v0[3] += bfhi(xr.y); v1[0] += bflo(xr.z); v1[1] += bfhi(xr.z); v1[2] += bflo(xr.w); v1[3] += bfhi(xr.w);
                    *(GAS f32x4*)(p) = v0; *(GAS f32x4*)(p + 4) = v1; } }
    }
};


namespace da {
typedef short bf16x8 __attribute__((ext_vector_type(8)));
typedef short s16x4 __attribute__((ext_vector_type(4)));
typedef float f32x16 __attribute__((ext_vector_type(16)));
typedef unsigned u32x4 __attribute__((ext_vector_type(4)));
typedef __attribute__((address_space(3))) const unsigned char* lds_cptr;
constexpr int SLOT = 32768, VOFF = 16384;
__device__ __forceinline__ int crow(int r, int hi) { return (r & 3) + 8 * (r >> 2) + 4 * hi; }
__device__ __forceinline__ void glds16(const void* gsrc, unsigned lds_dst) { unsigned keep;
    asm volatile("s_mov_b32 %0, m0\n\ts_mov_b32 m0, %2\n\ts_nop 0\n\tglobal_load_lds_dwordx4 %1, off\n\ts_mov_b32 m0, %0" : "=&s"(keep) : "v"(gsrc), "s"(lds_dst) : "memory"); }
typedef float f32x2_t __attribute__((ext_vector_type(2))); typedef __bf16 bf16x2_t __attribute__((ext_vector_type(2)));
__device__ __forceinline__ unsigned cvtpk(float lo, float hi) { f32x2_t v = {lo, hi}; bf16x2_t b = __builtin_convertvector(v, bf16x2_t); return __builtin_bit_cast(unsigned, b); }
typedef short v4i16_t __attribute__((ext_vector_type(4)));
__device__ __forceinline__ s16x4 vtr(lds_cptr p) { return __builtin_bit_cast(s16x4, __builtin_amdgcn_ds_read_tr16_b64_v4i16((__attribute__((address_space(3))) v4i16_t*)p)); }
#define DA_MFMA(a, b, c) __builtin_amdgcn_mfma_f32_32x32x16_bf16(a, b, c, 0, 0, 0)
#define DA_WAIT_BAR(N) asm volatile("s_waitcnt vmcnt(" #N ") lgkmcnt(0)\n\ts_barrier" ::: "memory")

#define DA_SB() __builtin_amdgcn_sched_barrier(0)
#define DA_PIN(x) asm volatile("" : "+v"(x))
#define DA_EX(S, A, r) do { S[r] = __builtin_amdgcn_exp2f(S[r]); A += S[r]; } while (0)
typedef const __attribute__((address_space(3))) bf16x8* lds_frag_ptr;
__device__ __forceinline__ void half_step(unsigned ka0, unsigned va0, unsigned va1, const bf16x8 (&q0)[4], const bf16x8 (&q1)[4], f32x16 (&O0)[4], f32x16 (&O1)[4], float& l0, float& l1, bool diag, int r32, int hi) {
#define DA_LDK(c, d0) (*(lds_frag_ptr)(size_t)(ka0 ^ (unsigned)((8 * (c) + 2 * (d0)) << 4)))
#define DA_VF(n) const s16x4 vl##n = vtr((lds_cptr)(size_t)((va0 + ((n) >> 2) * 4096) ^ (unsigned)(((n) & 3) << 6))), vh##n = vtr((lds_cptr)(size_t)((va1 + ((n) >> 2) * 4096) ^ (unsigned)(((n) & 3) << 6)))
#define DA_VFR(n) ((bf16x8){vl##n[0], vl##n[1], vl##n[2], vl##n[3], vh##n[0], vh##n[1], vh##n[2], vh##n[3]})
    f32x16 s0 = {}, s1 = {}; float a0 = 0.f, a1 = 0.f; u32x4 w00, w01, w10, w11;
    { const bf16x8 ka = DA_LDK(0, 0), kb = DA_LDK(0, 1), kc = DA_LDK(0, 2), kd = DA_LDK(0, 3); DA_SB();
      s0 = DA_MFMA(ka, q0[0], s0); s0 = DA_MFMA(kb, q0[1], s0); s0 = DA_MFMA(kc, q0[2], s0); s0 = DA_MFMA(kd, q0[3], s0); }
    const bf16x8 ke = DA_LDK(1, 0), kf = DA_LDK(1, 1), kg = DA_LDK(1, 2), kh_ = DA_LDK(1, 3);
    DA_SB();
    if (diag) {
#pragma unroll
        for (int r = 0; r < 16; ++r) { if (crow(r, hi) > r32) s0[r] = -INFINITY; }
    }
    DA_SB();
    s1 = DA_MFMA(ke, q1[0], s1); DA_EX(s0, a0, 0); DA_EX(s0, a0, 1); DA_PIN(s0); DA_PIN(a0); DA_SB();
    s1 = DA_MFMA(kf, q1[1], s1); DA_EX(s0, a0, 2); DA_EX(s0, a0, 3); w00.x = cvtpk(s0[0], s0[1]); w00.y = cvtpk(s0[2], s0[3]); DA_PIN(s0); DA_PIN(a0); DA_PIN(w00); DA_SB();
    DA_VF(0); DA_VF(1);
    s1 = DA_MFMA(kg, q1[2], s1); DA_EX(s0, a0, 4); DA_EX(s0, a0, 5); DA_PIN(s0); DA_PIN(a0); DA_SB();
    DA_VF(2); DA_VF(3);
    s1 = DA_MFMA(kh_, q1[3], s1); DA_EX(s0, a0, 6); DA_EX(s0, a0, 7); w00.z = cvtpk(s0[4], s0[5]); w00.w = cvtpk(s0[6], s0[7]); DA_PIN(s0); DA_PIN(a0); DA_PIN(w00); DA_SB();
    if (diag) {
#pragma unroll
        for (int r = 0; r < 16; ++r) { if (crow(r, hi) > r32) s1[r] = -INFINITY; }
    }
    DA_SB();
    const bf16x8 pa00 = __builtin_bit_cast(bf16x8, w00);
    O0[0] = DA_MFMA(pa00, DA_VFR(0), O0[0]); DA_EX(s1, a1, 0); DA_EX(s1, a1, 1); DA_PIN(s1); DA_PIN(a1); DA_SB();
    O0[1] = DA_MFMA(pa00, DA_VFR(1), O0[1]); DA_EX(s1, a1, 2); DA_EX(s1, a1, 3); w10.x = cvtpk(s1[0], s1[1]); w10.y = cvtpk(s1[2], s1[3]); DA_PIN(s1); DA_PIN(a1); DA_PIN(w10); DA_SB();
    O0[2] = DA_MFMA(pa00, DA_VFR(2), O0[2]); DA_EX(s1, a1, 4); DA_EX(s1, a1, 5); DA_PIN(s1); DA_PIN(a1); DA_SB();
    O0[3] = DA_MFMA(pa00, DA_VFR(3), O0[3]); DA_EX(s1, a1, 6); DA_EX(s1, a1, 7); w10.z = cvtpk(s1[4], s1[5]); w10.w = cvtpk(s1[6], s1[7]); DA_PIN(s1); DA_PIN(a1); DA_PIN(w10); DA_SB();
    const bf16x8 pa10 = __builtin_bit_cast(bf16x8, w10);
    O1[0] = DA_MFMA(pa10, DA_VFR(0), O1[0]); DA_EX(s0, a0, 8); DA_EX(s0, a0, 9); DA_PIN(s0); DA_PIN(a0); DA_SB();
    O1[1] = DA_MFMA(pa10, DA_VFR(1), O1[1]); DA_EX(s0, a0, 10); DA_EX(s0, a0, 11); w01.x = cvtpk(s0[8], s0[9]); w01.y = cvtpk(s0[10], s0[11]); DA_PIN(s0); DA_PIN(a0); DA_PIN(w01); DA_SB();
    DA_VF(4); DA_VF(5);
    O1[2] = DA_MFMA(pa10, DA_VFR(2), O1[2]); DA_EX(s0, a0, 12); DA_EX(s0, a0, 13); DA_PIN(s0); DA_PIN(a0); DA_SB();
    DA_VF(6); DA_VF(7);
    O1[3] = DA_MFMA(pa10, DA_VFR(3), O1[3]); DA_EX(s0, a0, 14); DA_EX(s0, a0, 15); w01.z = cvtpk(s0[12], s0[13]); w01.w = cvtpk(s0[14], s0[15]); DA_PIN(a0); DA_PIN(w01); DA_SB();
    const bf16x8 pa01 = __builtin_bit_cast(bf16x8, w01);
    O0[0] = DA_MFMA(pa01, DA_VFR(4), O0[0]); DA_EX(s1, a1, 8); DA_EX(s1, a1, 9); DA_PIN(s1); DA_PIN(a1); DA_SB();
    O0[1] = DA_MFMA(pa01, DA_VFR(5), O0[1]); DA_EX(s1, a1, 10); DA_EX(s1, a1, 11); w11.x = cvtpk(s1[8], s1[9]); w11.y = cvtpk(s1[10], s1[11]); DA_PIN(s1); DA_PIN(a1); DA_PIN(w11); DA_SB();
    O0[2] = DA_MFMA(pa01, DA_VFR(6), O0[2]); DA_EX(s1, a1, 12); DA_EX(s1, a1, 13); DA_PIN(s1); DA_PIN(a1); DA_SB();
    O0[3] = DA_MFMA(pa01, DA_VFR(7), O0[3]); DA_EX(s1, a1, 14); DA_EX(s1, a1, 15); w11.z = cvtpk(s1[12], s1[13]); w11.w = cvtpk(s1[14], s1[15]); DA_PIN(a1); DA_PIN(w11); DA_SB();
    const bf16x8 pa11 = __builtin_bit_cast(bf16x8, w11);
    O1[0] = DA_MFMA(pa11, DA_VFR(4), O1[0]); O1[1] = DA_MFMA(pa11, DA_VFR(5), O1[1]); O1[2] = DA_MFMA(pa11, DA_VFR(6), O1[2]); O1[3] = DA_MFMA(pa11, DA_VFR(7), O1[3]);
    l0 += a0; l1 += a1;
    DA_SB();
#undef DA_LDK
#undef DA_VF
#undef DA_VFR
}

__device__ __forceinline__ void attn_unit(int b, int h, int qb, const unsigned short* QD, const unsigned short* KD, const unsigned short* VD, unsigned short* OA, const float* subw, float lam,
                                          __attribute__((address_space(3))) unsigned char* shm, unsigned long long& tacc) {
#define DA_T0(k) unsigned long long tt_##k = 0; if (PROBE_TK == (k) && wid == PROBE_TW) tt_##k = __builtin_amdgcn_s_memrealtime()
#define DA_T1(k) if (PROBE_TK == (k) && wid == PROBE_TW) tacc += __builtin_amdgcn_s_memrealtime() - tt_##k
    int tid = threadIdx.x; asm volatile("" : "+v"(tid));
    const int lane = tid & 63, r32 = lane & 31, hi = lane >> 5; const int wid = __builtin_amdgcn_readfirstlane(tid >> 6);
    const size_t tok0 = (size_t)b * SEQ; const int q0 = qb * 256;
    const unsigned lds0 = (unsigned)(uintptr_t)shm;
    const int l4 = lane >> 4, rloc = 4 * wid + l4;
    const unsigned short* ksrc = KD + (tok0 + rloc) * 512 + h * 128 + ((lane & 15) ^ (rloc & 15)) * 8;
    const unsigned short* vsrc = VD + (tok0 + rloc) * 512 + h * 128 + ((lane & 15) ^ ((l4 << 2) | (wid & 3))) * 8;
    const unsigned kdst = lds0 + wid * 1024, vdst = lds0 + VOFF + wid * 1024;
#define DA_DMA(t, slot) do { const size_t o_ = (size_t)(t) * 64 * 512; \
        glds16(ksrc + o_, (unsigned)__builtin_amdgcn_readfirstlane(kdst + (slot))); glds16(ksrc + o_ + 32 * 512, (unsigned)__builtin_amdgcn_readfirstlane(kdst + (slot) + 8192)); \
        glds16(vsrc + o_, (unsigned)__builtin_amdgcn_readfirstlane(vdst + (slot))); glds16(vsrc + o_ + 32 * 512, (unsigned)__builtin_amdgcn_readfirstlane(vdst + (slot) + 8192)); } while (0)
    const int NT = 4 * (qb + 1);
    asm volatile("s_waitcnt vmcnt(0)" ::: "memory");
    DA_DMA(0, 0); DA_DMA(1, SLOT); DA_DMA(2, 2 * SLOT);
    bf16x8 q0f[4], q1f[4];
    { const unsigned short* qp = QD + (tok0 + q0 + wid * 32 + r32) * 512 + h * 128 + hi * 8;
#pragma unroll
      for (int d0 = 0; d0 < 4; ++d0) { q0f[d0] = *(const GAS bf16x8*)(qp + d0 * 16); q1f[d0] = *(const GAS bf16x8*)(qp + 64 + d0 * 16); } }
    asm volatile("" :: "v"(q0f[0]), "v"(q0f[1]), "v"(q0f[2]), "v"(q0f[3]), "v"(q1f[0]), "v"(q1f[1]), "v"(q1f[2]), "v"(q1f[3]));
    f32x16 O0[4], O1[4];
#pragma unroll
    for (int i = 0; i < 4; ++i) { O0[i] = f32x16{}; O1[i] = f32x16{}; }
    float l0 = 0.f, l1 = 0.f;
    const unsigned kab = lds0 + r32 * 256 + (((r32 & 15) ^ hi) << 4);
    unsigned vab[2];
    { const int q = (lane & 15) >> 2, p = lane & 3, g1 = (lane >> 4) & 1;
#pragma unroll
      for (int sec = 0; sec < 2; ++sec) vab[sec] = lds0 + VOFF + (4 * hi + q) * 256 + 64 * q + 16 * ((2 * g1 + (p >> 1)) ^ ((hi + 2 * sec) & 3)) + 8 * (p & 1) + sec * 2048; }
    const int HB = 2 * NT - 8;
    int slot = -SLOT, slot2 = 2 * SLOT;
    for (int hs = 0; hs < 2 * NT; ++hs) {
        const int t = hs >> 1;
        if ((hs & 1) == 0) {
            { DA_T0(1);
            if (t + 2 < NT) { DA_WAIT_BAR(8); } else if (t + 1 < NT) { DA_WAIT_BAR(4); } else { DA_WAIT_BAR(0); }
            DA_T1(1); }
            slot = slot == 3 * SLOT ? 0 : slot + SLOT; slot2 = slot2 == 3 * SLOT ? 0 : slot2 + SLOT;
            { DA_T0(2);
            if (wid < 4 && t + 3 < NT) DA_DMA(t + 3, slot2);
            DA_T1(2); }
        } else { DA_T0(2); if (wid >= 4 && t + 3 < NT) DA_DMA(t + 3, slot2); DA_T1(2); }
        const int rel = hs - HB - wid;
        if (rel <= 0) { const unsigned ho = (unsigned)(slot + (hs & 1) * 8192);
            DA_T0(3);
            half_step(kab + ho, vab[0] + ho, vab[1] + ho, q0f, q1f, O0, O1, l0, l1, rel == 0, r32, hi);
            DA_T1(3); }
    }
    DA_T0(4);
    l0 += __shfl_xor(l0, 32); l1 += __shfl_xor(l1, 32);
    asm volatile("s_waitcnt lgkmcnt(0)\n\ts_barrier" ::: "memory");
    __attribute__((address_space(3))) float* lw = (__attribute__((address_space(3))) float*)(shm + 65536) + wid * 64;
    if (hi == 0) { lw[r32] = __builtin_amdgcn_rcpf(l0); lw[32 + r32] = lam * __builtin_amdgcn_rcpf(l1); }
    asm volatile("s_waitcnt lgkmcnt(0)" ::: "memory");
    __attribute__((address_space(3))) unsigned short* stg = (__attribute__((address_space(3))) unsigned short*)(shm + wid * 8192);
    float sw[4];
#pragma unroll
    for (int db = 0; db < 4; ++db) sw[db] = ((const GAS float*)subw)[db * 32 + r32];
    float ssq[16];
#pragma unroll
    for (int r = 0; r < 16; ++r) { const float i0 = lw[crow(r, hi)], i1 = lw[32 + crow(r, hi)]; float s = 0.f;
#pragma unroll
        for (int db = 0; db < 4; ++db) { const float o = O0[db][r] * i0 - O1[db][r] * i1; O0[db][r] = o; s += o * o; }
        ssq[r] = s; }
#pragma unroll
    for (int o = 1; o < 32; o <<= 1) {
#pragma unroll
        for (int r = 0; r < 16; ++r) ssq[r] += __shfl_xor(ssq[r], o); }
#pragma unroll
    for (int r = 0; r < 16; ++r) { const float rs = (1.0f - LAMBDA_INIT) * __builtin_amdgcn_rsqf(ssq[r] * (1.0f / 128.0f) + 1e-5f); const int row = crow(r, hi);
#pragma unroll
        for (int db = 0; db < 4; ++db) stg[row * 128 + db * 32 + r32] = (unsigned short)cvtpk(O0[db][r] * rs * sw[db], 0.f); }
    asm volatile("s_waitcnt lgkmcnt(0)" ::: "memory");
    unsigned short* Ow = OA + (tok0 + q0 + wid * 32) * 1536 + h * 128;
#pragma unroll
    for (int i = 0; i < 8; ++i) { const int row = i * 4 + (lane >> 4), ch = lane & 15;
        const u32x4 v = *(const __attribute__((address_space(3))) u32x4*)(stg + row * 128 + ch * 8);
        *(GAS u32x4*)(Ow + (size_t)row * 1536 + ch * 8) = v; }
    asm volatile("s_waitcnt lgkmcnt(0)\n\ts_barrier" ::: "memory");
    DA_T1(4);
#undef DA_DMA
#undef DA_T0
#undef DA_T1
}
#undef DA_MFMA
#undef DA_WAIT_BAR
#undef DA_SB
#undef DA_PIN
#undef DA_EX
}

__device__ __forceinline__ void attn_phase(Frame& F, const Args& A) {
    const unsigned short* QD = (const unsigned short*)(F.ws + WS_QD); const unsigned short* KD = (const unsigned short*)(F.ws + WS_KD); const unsigned short* VD = (const unsigned short*)(F.ws + WS_VD);
    unsigned short* OA = (unsigned short*)(F.ws + WS_OA);
    const float lam = ((const GAS float*)(F.ws + WS_MISC))[0]; const float* subw = (const float*)A.in[10];
    const int bx = blockIdx.x, G = F.G;
    for (int it0 = (G % 8 == 0) ? (bx % 8) * (G / 8) + bx / 8 : bx; it0 < 256; it0 += G) {
        const int bh = it0 >> 3, s = it0 & 7, b = bh >> 2, h = bh & 3;
        for (int u = 0; u < 2; ++u) da::attn_unit(b, h, u == 0 ? 15 - s : s, QD, KD, VD, OA, subw, lam, F.lds, F.tacc);
    }
}


namespace rtn {
using da::bf16x8; using da::s16x4; using da::f32x16; using da::u32x4; using da::lds_cptr; using da::glds16; using da::cvtpk; using da::vtr; using da::crow;
#define RT_MFMA(a, b, c) __builtin_amdgcn_mfma_f32_32x32x16_bf16(a, b, c, 0, 0, 0)
#define RT_SB() __builtin_amdgcn_sched_barrier(0)
constexpr int KIMG = 0, VIMG = 32768, STATS = 98304;

__device__ __forceinline__ void dma_v(const unsigned short* VR, size_t tok0, int h, int wid, int lane, unsigned lds0) {
    const unsigned short* src = VR + (tok0 + 16 * wid + (lane >> 2)) * 1024 + h * 256 + (lane & 3) * 8;
#pragma unroll
    for (int i = 0; i < 8; ++i) glds16(src + i * 32, (unsigned)__builtin_amdgcn_readfirstlane(lds0 + VIMG + i * 8192 + wid * 1024));
}

__device__ __forceinline__ void stage_a_item(int item, const unsigned short* KR, const unsigned short* VR, unsigned short* KV, __attribute__((address_space(3))) unsigned char* shm) {
    int tid = threadIdx.x; asm volatile("" : "+v"(tid));
    const int lane = tid & 63, hi = lane >> 5; const int wid = __builtin_amdgcn_readfirstlane(tid >> 6);
    const int j = item & 31, bh = item >> 5, h = bh & 3, b = bh >> 2;
    const size_t tok0 = (size_t)b * SEQ + j * 128;
    const unsigned lds0 = (unsigned)(uintptr_t)shm;
    asm volatile("s_waitcnt vmcnt(0)" ::: "memory");
    { const unsigned short* src = KR + (tok0 + 16 * wid + (lane >> 2)) * 512 + h * 128 + (lane & 3) * 8;
#pragma unroll
      for (int i = 0; i < 4; ++i) glds16(src + i * 32, (unsigned)__builtin_amdgcn_readfirstlane(lds0 + KIMG + i * 8192 + wid * 1024)); }
    dma_v(VR, tok0, h, wid, lane, lds0);
    asm volatile("s_waitcnt vmcnt(0)\n\ts_barrier" ::: "memory");
    const lds_cptr trb = (lds_cptr)shm + ((lane >> 4) & 1) * 32 + (lane & 3) * 8 + (4 * hi + ((lane & 15) >> 2)) * 64;
    bf16x8 vf[8];
#pragma unroll
    for (int ks = 0; ks < 8; ++ks) { const s16x4 lo = vtr(trb + VIMG + wid * 8192 + ks * 1024), hh = vtr(trb + VIMG + wid * 8192 + ks * 1024 + 512);
        vf[ks] = (bf16x8){lo[0], lo[1], lo[2], lo[3], hh[0], hh[1], hh[2], hh[3]}; }
    unsigned short* dst = KV + (size_t)item * 32768 + (size_t)wid * 64 * 16 + lane * 16;
#pragma unroll
    for (int kb = 0; kb < 4; ++kb) {
        f32x16 acc = {};
#pragma unroll
        for (int ks = 0; ks < 8; ++ks) { const s16x4 lo = vtr(trb + KIMG + kb * 8192 + ks * 1024), hh = vtr(trb + KIMG + kb * 8192 + ks * 1024 + 512);
            const bf16x8 kf = (bf16x8){lo[0], lo[1], lo[2], lo[3], hh[0], hh[1], hh[2], hh[3]};
            acc = RT_MFMA(kf, vf[ks], acc); }
        u32x4 w0, w1;
        w0.x = cvtpk(acc[0], acc[1]); w0.y = cvtpk(acc[2], acc[3]); w0.z = cvtpk(acc[4], acc[5]); w0.w = cvtpk(acc[6], acc[7]);
        w1.x = cvtpk(acc[8], acc[9]); w1.y = cvtpk(acc[10], acc[11]); w1.z = cvtpk(acc[12], acc[13]); w1.w = cvtpk(acc[14], acc[15]);
        *(GAS u32x4*)(dst + (size_t)kb * 8 * 64 * 16) = w0; *(GAS u32x4*)(dst + (size_t)kb * 8 * 64 * 16 + 8) = w1;
    }
    asm volatile("s_waitcnt lgkmcnt(0)\n\ts_barrier" ::: "memory");
}

__device__ __forceinline__ void stage_b(const unsigned short* KV, unsigned short* ST, float lg0, float lg1, float lg2_, float lg3, int G) {
    const int NT = G * NWAVES * 64;
    for (int gt = blockIdx.x * (NWAVES * 64) + threadIdx.x; gt < BATCH * 4 * 4096; gt += NT) {
        const int bh = gt >> 12, e = gt & 4095, h = bh & 3;
        const float lg2 = h == 0 ? lg0 : (h == 1 ? lg1 : (h == 2 ? lg2_ : lg3)), g1 = exp2f(lg2), g127 = exp2f(127.0f * lg2), g128 = exp2f(128.0f * lg2);
        const GAS u32x4* src = (const GAS u32x4*)(KV + (size_t)bh * 32 * 32768) + e; GAS u32x4* dst = (GAS u32x4*)(ST + (size_t)bh * 32 * 32768) + e;
        float a[8];
#pragma unroll
        for (int i = 0; i < 8; ++i) a[i] = 0.f;
#pragma unroll 8
        for (int j = 0; j < 32; ++j) {
            u32x4 o; o.x = cvtpk(a[0] * g1, a[1] * g1); o.y = cvtpk(a[2] * g1, a[3] * g1); o.z = cvtpk(a[4] * g1, a[5] * g1); o.w = cvtpk(a[6] * g1, a[7] * g1);
            dst[(size_t)j * 4096] = o;
            if (j < 31) { const u32x4 k = src[(size_t)j * 4096];
                a[0] = g128 * a[0] + g127 * bflo(k.x); a[1] = g128 * a[1] + g127 * bfhi(k.x); a[2] = g128 * a[2] + g127 * bflo(k.y); a[3] = g128 * a[3] + g127 * bfhi(k.y);
                a[4] = g128 * a[4] + g127 * bflo(k.z); a[5] = g128 * a[5] + g127 * bfhi(k.z); a[6] = g128 * a[6] + g127 * bflo(k.w); a[7] = g128 * a[7] + g127 * bfhi(k.w); }
        }
    }
}

constexpr int STG = STATS + 2048;
__device__ __forceinline__ void dma_c(int item, const unsigned short* KR, const unsigned short* VR, int wid, int lane, unsigned lds0) {
    const int j = item & 31, bh = item >> 5, h = bh & 3, b = bh >> 2;
    const size_t tok0 = (size_t)b * SEQ + j * 128;
    const unsigned short* src = KR + (tok0 + 64 * (wid & 1) + lane) * 512 + h * 128 + (wid >> 1) * 8;
#pragma unroll
    for (int i = 0; i < 4; ++i) glds16(src + i * 32, (unsigned)__builtin_amdgcn_readfirstlane(lds0 + KIMG + (wid + 8 * i) * 1024));
    dma_v(VR, tok0, h, wid, lane, lds0);
}
__device__ __forceinline__ void stage_c_items(int item0, int NI, const unsigned short* QR, const unsigned short* KR, const unsigned short* VR, const unsigned short* ST, const unsigned short* GS, const float* gnw,
                                              unsigned short* ORR, __attribute__((address_space(3))) unsigned char* shm, unsigned long long& tacc) {
    const int wid = __builtin_amdgcn_readfirstlane(threadIdx.x >> 6), rb = wid >> 1, dh = wid & 1;
    unsigned long long tt_ = 0;
#define RC_T0(k) do { if (PROBE_TK == (k) && wid == PROBE_TW) { RT_SB(); tt_ = __builtin_amdgcn_s_memrealtime(); RT_SB(); } } while (0)
#define RC_T1(k) do { if (PROBE_TK == (k) && wid == PROBE_TW) { RT_SB(); tacc += __builtin_amdgcn_s_memrealtime() - tt_; RT_SB(); } } while (0)
    const unsigned lds0 = (unsigned)(uintptr_t)shm;
    asm volatile("s_waitcnt vmcnt(0) lgkmcnt(0)\n\ts_barrier" ::: "memory");
    dma_c(item0, KR, VR, wid, threadIdx.x & 63, lds0);
    for (int ii = 0; ii < NI; ++ii) {
        int tid = threadIdx.x; asm volatile("" : "+v"(tid));
        const int lane = tid & 63, r32 = lane & 31, hi = lane >> 5;
        const int item = item0 + ii, j = item & 31, bh = item >> 5, h = bh & 3, b = bh >> 2;
        const size_t tok0 = (size_t)b * SEQ + j * 128;
        RC_T0(21);
        bf16x8 qn[8];
        { const unsigned short* qp = QR + (tok0 + 32 * rb + r32) * 512 + h * 128 + hi * 8;
#pragma unroll
          for (int s = 0; s < 8; ++s) qn[s] = *(const GAS bf16x8*)(qp + s * 16); }
        f32x16 O[4];
#pragma unroll
        for (int i = 0; i < 4; ++i) O[i] = f32x16{};
        if (j > 0) {
            const unsigned short* sp = ST + (size_t)item * 32768 + (size_t)(4 * dh) * 64 * 16 + lane * 16;
            bf16x8 fa[2][4], fb[2][4];
#define RC_LOAD(f, q) do { _Pragma("unroll") for (int s2 = 0; s2 < 2; ++s2) _Pragma("unroll") for (int db = 0; db < 4; ++db) f[s2][db] = *(const GAS bf16x8*)(sp + (size_t)((q) * 8 + db) * 64 * 16 + s2 * 8); } while (0)
#define RC_USE(f, q) do { _Pragma("unroll") for (int s2 = 0; s2 < 2; ++s2) { const u32x4 qv = __builtin_bit_cast(u32x4, qn[2 * (q) + s2]); \
                const auto r0 = __builtin_amdgcn_permlane32_swap(qv.x, qv.z, false, false), r1 = __builtin_amdgcn_permlane32_swap(qv.y, qv.w, false, false); \
                u32x4 pv; pv.x = r0[0]; pv.y = r1[0]; pv.z = r0[1]; pv.w = r1[1]; const bf16x8 qa = __builtin_bit_cast(bf16x8, pv); \
                _Pragma("unroll") for (int db = 0; db < 4; ++db) O[db] = RT_MFMA(qa, f[s2][db], O[db]); } } while (0)
            RC_LOAD(fa, 0); RC_LOAD(fb, 1); RT_SB();
            RC_USE(fa, 0); RT_SB(); RC_LOAD(fa, 2); RT_SB();
            RC_USE(fb, 1); RT_SB(); RC_LOAD(fb, 3); RT_SB();
            RC_USE(fa, 2); RT_SB(); RC_USE(fb, 3); RT_SB();
#undef RC_LOAD
#undef RC_USE
        }
        RC_T1(21); RC_T0(22);
        asm volatile("s_waitcnt vmcnt(0)\n\ts_barrier" ::: "memory");
        RC_T1(22); RC_T0(23);
        const size_t obase = (tok0 + 32 * rb) * 1024 + h * 256 + 128 * dh;
        u32x4 gpre[8];
#pragma unroll
        for (int i = 0; i < 8; ++i) { const int hf = i >> 2, row = (i & 3) * 8 + (lane >> 3), ch = lane & 7; gpre[i] = *(const GAS u32x4*)(GS + obase + (size_t)row * 1024 + hf * 64 + ch * 8); }
        const lds_cptr kp = (lds_cptr)shm + KIMG + hi * 2048 + r32 * 16;
        const lds_cptr vp = (lds_cptr)shm + VIMG + (4 * dh) * 8192 + ((lane >> 4) & 1) * 32 + (lane & 3) * 8 + (4 * hi + ((lane & 15) >> 2)) * 64;
        for (int kb = 0; kb <= rb; ++kb) {
            f32x16 s = {};
#pragma unroll
            for (int ks = 0; ks < 8; ++ks) { const bf16x8 kf = *(const __attribute__((address_space(3))) bf16x8*)(kp + ks * 4096 + kb * 512); s = RT_MFMA(kf, qn[ks], s); }
            if (kb == rb) {
#pragma unroll
                for (int r = 0; r < 16; ++r) { if (crow(r, hi) > r32) s[r] = 0.f; }
            }
            RT_SB();
            u32x4 w0, w1;
            w0.x = cvtpk(s[0], s[1]); w0.y = cvtpk(s[2], s[3]); w0.z = cvtpk(s[4], s[5]); w0.w = cvtpk(s[6], s[7]);
            w1.x = cvtpk(s[8], s[9]); w1.y = cvtpk(s[10], s[11]); w1.z = cvtpk(s[12], s[13]); w1.w = cvtpk(s[14], s[15]);
            const bf16x8 pa0 = __builtin_bit_cast(bf16x8, w0), pa1 = __builtin_bit_cast(bf16x8, w1);
#pragma unroll
            for (int i = 0; i < 8; ++i) { const int ks2 = i >> 2, db = i & 3;
                const s16x4 lo = vtr(vp + db * 8192 + (2 * kb + ks2) * 1024), hh = vtr(vp + db * 8192 + (2 * kb + ks2) * 1024 + 512);
                const bf16x8 vf = (bf16x8){lo[0], lo[1], lo[2], lo[3], hh[0], hh[1], hh[2], hh[3]};
                O[db] = RT_MFMA(ks2 == 0 ? pa0 : pa1, vf, O[db]); }
            RT_SB();
        }
        RC_T1(23); RC_T0(24);
        float s1[16], s2[16];
#pragma unroll
        for (int r = 0; r < 16; ++r) { float a = 0.f, q = 0.f;
#pragma unroll
            for (int db = 0; db < 4; ++db) { a += O[db][r]; q += O[db][r] * O[db][r]; }
            s1[r] = a; s2[r] = q; }
#pragma unroll
        for (int o = 1; o < 32; o <<= 1) {
#pragma unroll
            for (int r = 0; r < 16; ++r) { s1[r] += __shfl_xor(s1[r], o); s2[r] += __shfl_xor(s2[r], o); } }
        typedef float f32x2v __attribute__((ext_vector_type(2)));
        __attribute__((address_space(3))) f32x2v* stt = (__attribute__((address_space(3))) f32x2v*)(shm + STATS);
        if (r32 == 0) {
#pragma unroll
            for (int r = 0; r < 16; ++r) stt[wid * 32 + crow(r, hi)] = (f32x2v){s1[r], s2[r]};
        }
        RC_T1(24); RC_T0(25);
        asm volatile("s_waitcnt vmcnt(0) lgkmcnt(0)\n\ts_barrier" ::: "memory");
        RC_T1(25); RC_T0(26);
        float gw[2][2];
#pragma unroll
        for (int hf = 0; hf < 2; ++hf)
#pragma unroll
            for (int d2 = 0; d2 < 2; ++d2) gw[hf][d2] = ((const GAS float*)gnw)[h * 256 + 128 * dh + hf * 64 + d2 * 32 + r32];
        asm volatile("" :: "v"(gw[0][0]), "v"(gw[0][1]), "v"(gw[1][0]), "v"(gw[1][1]), "v"(gpre[0]), "v"(gpre[1]), "v"(gpre[2]), "v"(gpre[3]), "v"(gpre[4]), "v"(gpre[5]), "v"(gpre[6]), "v"(gpre[7]));
        if (ii + 1 < NI) dma_c(item + 1, KR, VR, wid, lane, lds0);
        __attribute__((address_space(3))) unsigned short* stg = (__attribute__((address_space(3))) unsigned short*)(shm + STG + wid * 4096);
        float mu_[16], rs_[16];
#pragma unroll
        for (int r = 0; r < 16; ++r) { const int row = crow(r, hi); const f32x2v pa = stt[wid * 32 + row], pb = stt[(wid ^ 1) * 32 + row];
            const float mu = (pa.x + pb.x) * (1.0f / 256.0f), var = (pa.y + pb.y) * (1.0f / 256.0f) - mu * mu; mu_[r] = mu; rs_[r] = __builtin_amdgcn_rsqf(var + 1e-5f); }
#pragma unroll
        for (int hf = 0; hf < 2; ++hf) {
#pragma unroll
            for (int r = 0; r < 16; ++r) { const int row = crow(r, hi);
#pragma unroll
                for (int d2 = 0; d2 < 2; ++d2) stg[row * 64 + d2 * 32 + r32] = (unsigned short)cvtpk((O[2 * hf + d2][r] - mu_[r]) * rs_[r] * gw[hf][d2], 0.f); }
            asm volatile("s_waitcnt lgkmcnt(0)" ::: "memory");
#pragma unroll
            for (int i = 0; i < 4; ++i) { const int row = i * 8 + (lane >> 3), ch = lane & 7;
                const u32x4 v = *(const __attribute__((address_space(3))) u32x4*)(stg + row * 64 + ch * 8);
                const u32x4 g = gpre[hf * 4 + i];
                u32x4 o; o.x = cvtpk(bflo(v.x) * bflo(g.x), bfhi(v.x) * bfhi(g.x)); o.y = cvtpk(bflo(v.y) * bflo(g.y), bfhi(v.y) * bfhi(g.y));
                o.z = cvtpk(bflo(v.z) * bflo(g.z), bfhi(v.z) * bfhi(g.z)); o.w = cvtpk(bflo(v.w) * bflo(g.w), bfhi(v.w) * bfhi(g.w));
                *(GAS u32x4*)(ORR + (tok0 + 32 * rb + row) * 1536 + 512 + h * 256 + 128 * dh + hf * 64 + ch * 8) = o; }
            asm volatile("s_waitcnt lgkmcnt(0)" ::: "memory");
        }
        RC_T1(26);
    }
    asm volatile("s_waitcnt vmcnt(0) lgkmcnt(0)\n\ts_barrier" ::: "memory");
#undef RC_T0
#undef RC_T1
}
#undef RT_MFMA
#undef RT_SB
}

__device__ __forceinline__ int vcu_of(int bx, int G) { return (G % 8 == 0) ? (bx % 8) * (G / 8) + bx / 8 : bx; }
__device__ __forceinline__ void ret_a_phase(Frame& F) {
    for (int it = 4 * vcu_of(blockIdx.x, F.G); it < BATCH * 4 * 32; it += 4 * F.G)
        for (int k = 0; k < 4; ++k) rtn::stage_a_item(it + k, (const unsigned short*)(F.ws + WS_KR), (const unsigned short*)(F.ws + WS_VR), (unsigned short*)(F.ws + WS_KV), F.lds);
}
__device__ __forceinline__ void ret_c_phase(Frame& F, const Args& A) {
    for (int it = 4 * vcu_of(blockIdx.x, F.G); it < BATCH * 4 * 32; it += 4 * F.G)
        rtn::stage_c_items(it, 4, (const unsigned short*)(F.ws + WS_QR), (const unsigned short*)(F.ws + WS_KR), (const unsigned short*)(F.ws + WS_VR), (const unsigned short*)(F.ws + WS_ST),
                           (const unsigned short*)(F.ws + WS_GS), (const float*)A.in[12], (unsigned short*)(F.ws + WS_OA), F.lds, F.tacc);
}


__global__ void __launch_bounds__(NWAVES * 64, 2) hybrid_fwd(Args args) {
    extern __shared__ __attribute__((aligned(16))) unsigned char lds[];
    Frame F;
    F.lds = (LAS unsigned char*)lds; F.MISC = (volatile LAS unsigned*)(F.lds + MISC_OFF);
    F.tid = threadIdx.x; F.lane = F.tid & 63; F.wave = __builtin_amdgcn_readfirstlane(F.tid >> 6); F.G = gridDim.x;
    F.ws = args.ws; F.ctl = (gu32*)(args.ws + WS_CTL); F.tacc = 0;
    for (int u = F.tid; u < (LDS_BYTES - MISC_OFF) / 4; u += NWAVES * 64) ((LAS unsigned*)(F.lds + MISC_OFF))[u] = 0u;
    __syncthreads();
    XcdBarrier bar; bar.bar = (unsigned*)(F.ctl + CW_BAR) + args.li * XCD_BAR_WORDS; bar.x = 0; bar.st = nullptr;
    if (MK_N_LAUNCHES != N_PHASES) bar = xcd_barrier_post((unsigned*)(F.ctl + CW_BAR) + args.li * XCD_BAR_WORDS, F.MISC + 8);
    const int lo = args.ph_lo, hi = args.ph_hi;
#define IN(k) (lo <= (k) && (k) < hi)
#ifndef PROBE_CLK
#define PROBE_CLK -1
#define PROBE_CLK_E -1
#define PROBE_CLK_DUR 0
#endif
    unsigned long long clk_m0 = 0, clk_r0 = 0, clk_ticks = 0;
#define CLK_BEG(k) do { if (PROBE_CLK == (k) && blockIdx.x == 0) { clk_m0 = __builtin_amdgcn_s_memtime(); clk_r0 = __builtin_amdgcn_s_memrealtime(); } } while (0)
#define CLK_END(k) do { if (PROBE_CLK_E == (k) && blockIdx.x == 0) { const unsigned long long dm = __builtin_amdgcn_s_memtime() - clk_m0, dr = __builtin_amdgcn_s_memrealtime() - clk_r0; clk_ticks = PROBE_CLK_DUR ? dr : (unsigned long long)((double)dm * 1000.0 / (double)dr); } } while (0)
#ifndef PROBE_BAR2
#define PROBE_BAR2 0
#endif
#define SEAM(k) do { if (IN(k) && IN((k) + 1)) { xcd_barrier(bar); if (PROBE_BAR2) xcd_barrier(bar); } } while (0)
#ifndef PROBE_DUP
#define PROBE_DUP 0
#endif
#define REP(k) for (int rep_ = 0; rep_ < 1 + ((PROBE_DUP >> (k)) & 1); ++rep_)
#define PHASE_WS() unsigned char* ws = args.ws; asm volatile("" : "+s"(ws)); F.ws = ws
    if (IN(0)) { PHASE_WS(); CLK_BEG(0); REP(0) p0_prologue(F, args); CLK_END(0); SEAM(0); }
    if (IN(1)) { PHASE_WS(); CLK_BEG(1); REP(1) {
        pg8::Gemm g{(const bf16_t*)(ws + WS_XN), (const bf16_t*)(ws + WS_WIN), M, INW, DM}; pg8::StaticOrder S; S.init(M, INW, F.G, (int)blockIdx.x);
        EpiProj E{(bf16_t*)(ws + WS_QD), (bf16_t*)(ws + WS_KD), (bf16_t*)(ws + WS_QR), (bf16_t*)(ws + WS_KR), (bf16_t*)args.out, ws,
                  (const int*)args.in[1], (const float*)args.in[4], (const float*)args.in[5], args.lg2[0], args.lg2[1], args.lg2[2], args.lg2[3]};
        pg8::gemm_phase<EpiProj, pg8::StaticOrder, true, true>(F.lds, g, S, E); }
        CLK_END(1); SEAM(1);
    }
    if (IN(2)) { PHASE_WS();
        if ((blockIdx.x >> 3) & 1) { ret_a_phase(F); attn_phase(F, args); } else { attn_phase(F, args); ret_a_phase(F); }
        SEAM(2); }
    if (IN(3)) { PHASE_WS(); CLK_BEG(3); REP(3) rtn::stage_b((const unsigned short*)(ws + WS_KV), (unsigned short*)(ws + WS_ST), args.lg2[0], args.lg2[1], args.lg2[2], args.lg2[3], F.G); CLK_END(3); SEAM(3); }
    if (IN(4)) { PHASE_WS(); CLK_BEG(4); REP(4) ret_c_phase(F, args); CLK_END(4); SEAM(4); }
    if (IN(5)) { PHASE_WS(); CLK_BEG(5); REP(5) {
        pg8::Gemm g{(const bf16_t*)(ws + WS_OA), (const bf16_t*)(ws + WS_WA), M, DM, 1536}; pg8::StaticOrder S; S.init(M, DM, F.G, (int)blockIdx.x);
        EpiMerge2 E{(const bf16_t*)args.out, (bf16_t*)(ws + WS_MRG)};
        pg8::gemm_phase<EpiMerge2, pg8::StaticOrder, true, true>(F.lds, g, S, E); }
        CLK_END(5); SEAM(5);
    }
    if (IN(6)) { PHASE_WS(); CLK_BEG(6); REP(6) {
        pg8::Gemm g{(const bf16_t*)(ws + WS_MRG), (const bf16_t*)(ws + WS_WO), M, DM, DM}; pg8::StaticOrder S; S.init(M, DM, F.G, (int)blockIdx.x);
        EpiX1 E{(const float*)args.in[0], args.out, (bf16_t*)(ws + WS_XN), (float*)(ws + WS_RSS)};
        pg8::gemm_phase<EpiX1, pg8::StaticOrder, true, true>(F.lds, g, S, E); }
        CLK_END(6); SEAM(6);
    }
    if (IN(7)) { PHASE_WS(); CLK_BEG(7);
#if PROBE_XCC
        { const unsigned xcc = xb_xcc_id(); if (xcc != (blockIdx.x & 7u)) { if (F.tid == 0) { ((GAS float*)(ws + WS_RSS))[0] = __builtin_nanf(""); } } }
#endif
        for (int hf_ = 0; hf_ < 2; ++hf_) {
            int hf = hf_; asm volatile("" : "+s"(hf));
            const size_t r0 = (size_t)hf * (M / 2);
            { pg8::Gemm g{(const bf16_t*)(ws + WS_XN) + r0 * DM, (const bf16_t*)(ws + WS_W1), M / 2, FF, DM}; pg8::StaticOrder S; S.init(M / 2, FF, F.G, (int)blockIdx.x);
              EpiHid E{(const float*)(ws + WS_RSS) + r0 * 16, (bf16_t*)(ws + WS_HID) + r0 * FF};
              pg8::gemm_phase<EpiHid, pg8::StaticOrder, true, true>(F.lds, g, S, E); }
            xcd_barrier(bar);
            { pg8::Gemm g{(const bf16_t*)(ws + WS_HID) + r0 * FF, (const bf16_t*)(ws + WS_W2), M / 2, DM, FF}; RevOrder S; S.init(M / 2, DM, F.G, (int)blockIdx.x);
              EpiOut E{args.out + r0 * DM, (const bf16_t*)(ws + WS_XN) + r0 * DM};
              pg8::gemm_phase<EpiOut, RevOrder, true, true>(F.lds, g, S, E); }
        }
        CLK_END(7);
    }
    if (PROBE_TK > 0 && blockIdx.x == 0 && F.wave == PROBE_TW) { const unsigned long long t0 = __builtin_amdgcn_s_memrealtime(), tk = (PROBE_TK >= 5 && PROBE_TK < 20 ? (unsigned long long)*(LAS unsigned*)(F.lds + LDS_BYTES - 128) : F.tacc) * PROBE_TS; while (__builtin_amdgcn_s_memrealtime() - t0 < tk) __builtin_amdgcn_s_sleep(20); }
    if (PROBE_CLK >= 0 && blockIdx.x == 0 && F.wave == 0) { const unsigned long long t0 = __builtin_amdgcn_s_memrealtime(); while (__builtin_amdgcn_s_memrealtime() - t0 < clk_ticks) __builtin_amdgcn_s_sleep(20); }
#undef IN
#undef SEAM
}

extern "C" void kernel_launch(void* const* d_in, const int* in_sizes, int n_in, void* d_out, int out_size, void* d_ws, size_t ws_size, hipStream_t stream) {
    static int grid = 0;
    if (grid == 0) {
        if (n_in != 18 || in_sizes[0] != M * DM || out_size != M * DM || ws_size < WS_END) { fprintf(stderr, "kernel_launch: unexpected shapes (n_in %d, in0 %d, out %d, ws %zu)\n", n_in, n_in > 0 ? in_sizes[0] : -1, out_size, ws_size); grid = -1; return; }
        int dev = 0, cus = 0;
        if (hipGetDevice(&dev) != hipSuccess || hipDeviceGetAttribute(&cus, hipDeviceAttributeMultiprocessorCount, dev) != hipSuccess) { grid = -1; return; }
        if (hipFuncSetAttribute((const void*)hybrid_fwd, hipFuncAttributeMaxDynamicSharedMemorySize, LDS_BYTES) != hipSuccess) { fprintf(stderr, "kernel_launch: hipFuncSetAttribute failed\n"); grid = -1; return; }
        int per_cu = 0;
        if (hipOccupancyMaxActiveBlocksPerMultiprocessor(&per_cu, (const void*)hybrid_fwd, NWAVES * 64, LDS_BYTES) != hipSuccess || per_cu < 1) fprintf(stderr, "kernel_launch: occupancy query says %d\n", per_cu);
        (void)hipGetLastError();
        grid = cus;
    }
    if (grid < 0) return;
    hipMemsetAsync((char*)d_ws + WS_CTL, 0, CTL_ZERO_BYTES, stream);
    Args a{};
    for (int i = 0; i < 18; ++i) a.in[i] = d_in[i];
    a.out = (float*)d_out; a.ws = (unsigned char*)d_ws;
    for (int j = 0; j < 8; ++j) a.invf[j] = std::pow(500000.0, -(double)(2 * j) / 16.0);
    for (int j = 0; j < 64; ++j) a.invf[8 + j] = 1.0 / std::pow(10000.0, (double)j / 63.0);
    for (int hh = 0; hh < 4; ++hh) a.lg2[hh] = (float)std::log2(1.0 - std::exp2(-5.0 - (double)hh));
    const int nl = MK_N_LAUNCHES;
    for (int li = 0; li < nl; ++li) {
        if (nl == N_PHASES) { a.ph_lo = li; a.ph_hi = li + 1; a.li = 0; }
        else { a.ph_lo = li * N_PHASES / nl; a.ph_hi = (li + 1) * N_PHASES / nl; a.li = li; }
        hipLaunchKernelGGL(hybrid_fwd, dim3(grid), dim3(NWAVES * 64), LDS_BYTES, stream, a);
    }
}
```

```cpp
#include <hip/hip_runtime.h>
#include <cstdio>
#include <cstdint>
#include <cmath>
namespace pg8 {
#define PG8_LAS __attribute__((address_space(3)))
typedef unsigned short bf16_t;
typedef short bf16x8 __attribute__((ext_vector_type(8)));
typedef float f32x4 __attribute__((ext_vector_type(4)));
typedef unsigned u32x4 __attribute__((ext_vector_type(4)));
constexpr int BM = 256, BK = 64, HALF = 128, HTB = HALF * BK * 2  , STAGE_BYTES = 8 * HTB, NXCD = 8, WGM = 8;

__host__ __device__ __forceinline__ int lds_byte(int r, int c) { const int st = (r >> 4) * 2 + (c >> 5), rr = r & 15, cc = c & 31, ob = rr * 64 + cc * 2; return st * 1024 + (ob ^ (((ob >> 9) & 1) << 5)); }
__host__ __device__ __forceinline__ void stage_rc(int b, int& R, int& C) { const int st = b / 1024, sb = b % 1024, swz = sb ^ (((sb >> 9) & 1) << 5); R = (st >> 1) * 16 + swz / 64; C = (st & 1) * 32 + (swz % 64) / 2; }
__host__ __device__ __forceinline__ int perm32(int rho) { const int n = rho >> 4, i = rho & 15; return 8 * (i >> 2) + 4 * n + (i & 3); }

struct Unit { int pm, pn; };
struct Gemm { const bf16_t* A; const bf16_t* Bt; int M, N, K; };

struct StaticOrder {
    int nM, nN, nwg, G, c;
    __host__ __device__ void init(int M, int N, int G_, int c_) { nM = M / BM; nN = N / BM; nwg = nM * nN; G = G_; c = c_; }
    __host__ __device__ bool next(int i, Unit& u) const {
        const long L = (long)i * G + c; if (L >= nwg) return false;
        int wgid = (int)L; { const int q = nwg / NXCD, r = nwg % NXCD, xcd = wgid % NXCD, off = wgid / NXCD; wgid = (xcd < r ? xcd * (q + 1) : r * (q + 1) + (xcd - r) * q) + off; }
        const int nig = WGM * nN, gid = wgid / nig, fm = gid * WGM, gsz = (nM - fm) < WGM ? (nM - fm) : WGM;
        u.pm = fm + ((wgid % nig) % gsz); u.pn = (wgid % nig) / gsz; return true;
    }
    __device__ __forceinline__ void a_ready(const Unit&) const {}
    __device__ __forceinline__ void done(const Unit&) const {}
};

__device__ __forceinline__ unsigned cvt_pk_bf16(float lo, float hi) { unsigned r; asm volatile("v_cvt_pk_bf16_f32 %0, %1, %2" : "=v"(r) : "v"(lo), "v"(hi)); return r; }
typedef float f32x2 __attribute__((ext_vector_type(2)));
#define PROBE_TK 0
#define PROBE_TAG 1
#define PROBE_TW 0
#define PROBE_TS 1
template <class Epi, class Sched, bool ALIGN_EPI = false, bool SP2 = false>
__device__ __forceinline__ void gemm_phase(PG8_LAS unsigned char* lds, const Gemm g, const Sched& S, const Epi& E) {
    int tid_ = threadIdx.x; asm volatile("" : "+v"(tid_));
    const int tid = tid_, wid = __builtin_amdgcn_readfirstlane(tid >> 6), lane = tid & 63, wr = wid >> 2, wc = wid & 3, fr = lane & 15, fq = lane >> 4;
    const int K = g.K, nt = K / BK;
    unsigned voffA[2], voffB[2];
#pragma unroll
    for (int i = 0; i < 2; ++i) { int R, C; stage_rc(tid * 16 + i * 8192, R, C); const int Rb = Epi::PERM ? ((R & ~31) + perm32(R & 31)) : R;
        voffA[i] = Epi::ABLK ? (unsigned)(((R >> 4) * (K / 32) + (C >> 5)) * 1024 + ((R & 15) * 4 + ((C & 31) >> 3)) * 16) : (unsigned)(R * K + C) * 2u; voffB[i] = Epi::BBLK ? (unsigned)(((Rb >> 4) * (K / 32) + (C >> 5)) * 1024 + ((Rb & 15) * 4 + ((C & 31) >> 3)) * 16) : (unsigned)(Rb * K + C) * 2u; }
    const size_t kstep = (size_t)(BK * 2);
    const size_t kstepB = Epi::BBLK ? (size_t)2048 : kstep;
    const size_t kstepA = Epi::ABLK ? (size_t)2048 : kstep;
    const size_t hstep = (size_t)HALF * K * 2;
    const size_t tstep = 2 * hstep;
    const unsigned ldsw = (unsigned)wid * 1024u; const unsigned lds0_ = (unsigned)__builtin_amdgcn_readfirstlane((int)((unsigned)(size_t)lds + (unsigned)wid * 1024u));
    const int aoff = lds_byte(wr * 64 + fr, fq * 8), boff = lds_byte(wc * 32 + fr, fq * 8);
#define PG8_SA(b, h) (((b) * 2 + (h)) * HTB)
#define PG8_SB(b, h) ((4 + (b) * 2 + (h)) * HTB)
#define PG8_STAGE(bufoff, gbase, voff) do { unsigned keep_; const unsigned d0_ = lds0_ + (unsigned)(bufoff), d1_ = d0_ + 8192u; \
        asm volatile("s_mov_b32 %0, m0\n\ts_mov_b32 m0, %3\n\ts_nop 0\n\tglobal_load_lds_dwordx4 %1, %5\n\ts_mov_b32 m0, %4\n\ts_nop 0\n\tglobal_load_lds_dwordx4 %2, %5\n\ts_mov_b32 m0, %0" \
                     : "=&s"(keep_) : "v"((voff)[0]), "v"((voff)[1]), "s"(d0_), "s"(d1_), "s"((const char*)(gbase)) : "memory"); } while (0)
#define PG8_LDA(dst, b, h) do { _Pragma("unroll") for (int m = 0; m < 4; ++m) _Pragma("unroll") for (int k = 0; k < 2; ++k) dst[m][k] = *(const PG8_LAS bf16x8*)(lds + PG8_SA(b, h) + aoff + m * 2048 + k * 1024); } while (0)
#define PG8_LDB(dst, b, h) do { _Pragma("unroll") for (int n = 0; n < 2; ++n) _Pragma("unroll") for (int k = 0; k < 2; ++k) dst[n][k] = *(const PG8_LAS bf16x8*)(lds + PG8_SB(b, h) + boff + n * 2048 + k * 1024); } while (0)
#define PG8_MMA(ai, bj, At, Bt) do { __builtin_amdgcn_s_setprio(1); _Pragma("unroll") for (int m = 0; m < 4; ++m) _Pragma("unroll") for (int n = 0; n < 2; ++n) _Pragma("unroll") for (int k = 0; k < 2; ++k) \
        acc[ai][bj][m][n] = __builtin_amdgcn_mfma_f32_16x16x32_bf16(Bt[n][k], At[m][k], acc[ai][bj][m][n], 0, 0, 0); __builtin_amdgcn_s_setprio(0); } while (0)
#define PG8_WAIT_V(n) asm volatile("s_waitcnt vmcnt(" #n ")" ::: "memory")
#define PG8_WAIT_L(n) asm volatile("s_waitcnt lgkmcnt(" #n ")" ::: "memory")
#define PG8_BAR __builtin_amdgcn_s_barrier()
#define PG8_SCHED __builtin_amdgcn_sched_barrier(0)
    unsigned long long tprev_ = 0, tloc_ = 0;
#define PG8_T0(k) do { if (PROBE_TK == (k) && Epi::TAG == PROBE_TAG && wid == PROBE_TW) { PG8_SCHED; tprev_ = __builtin_amdgcn_s_memrealtime(); PG8_SCHED; } } while (0)
#define PG8_T1(k) do { if (PROBE_TK == (k) && Epi::TAG == PROBE_TAG && wid == PROBE_TW) { PG8_SCHED; tloc_ += __builtin_amdgcn_s_memrealtime() - tprev_; PG8_SCHED; } } while (0)
    Unit cur, nxt; int ui = 0;
    if (!S.next(0, cur)) return;
    f32x4 acc[2][2][4][2];
#pragma unroll
    for (int a = 0; a < 2; ++a)
#pragma unroll
        for (int b = 0; b < 2; ++b)
#pragma unroll
            for (int m = 0; m < 4; ++m)
#pragma unroll
                for (int n = 0; n < 2; ++n) acc[a][b][m][n] = (f32x4){0.f, 0.f, 0.f, 0.f};
    bf16x8 At[4][2], B0[2][2], B1[2][2];
    const char* cA = (const char*)g.A + (size_t)cur.pm * tstep; const char* cB = (const char*)g.Bt + (size_t)cur.pn * tstep;
    S.a_ready(cur);
    if constexpr (SP2) {
        PG8_STAGE(PG8_SB(0, 0), cB, voffB); PG8_STAGE(PG8_SB(0, 1), cB + hstep, voffB); PG8_STAGE(PG8_SA(0, 0), cA, voffA); PG8_STAGE(PG8_SA(0, 1), cA + hstep, voffA);
        if (wr == 1) PG8_BAR;
        PG8_WAIT_V(2); PG8_BAR;
        PG8_STAGE(PG8_SB(1, 0), cB + kstepB, voffB); PG8_STAGE(PG8_SA(1, 0), cA + kstepA, voffA); PG8_STAGE(PG8_SB(1, 1), cB + hstep + kstepB, voffB);
        PG8_WAIT_V(6); PG8_BAR;
    } else {
        PG8_STAGE(PG8_SB(0, 0), cB, voffB); PG8_STAGE(PG8_SA(0, 0), cA, voffA); PG8_STAGE(PG8_SB(0, 1), cB + hstep, voffB); PG8_STAGE(PG8_SA(0, 1), cA + hstep, voffA);
        if (wr == 1) PG8_BAR;
        PG8_WAIT_V(4); PG8_BAR;
        PG8_STAGE(PG8_SB(1, 0), cB + kstepB, voffB); PG8_STAGE(PG8_SA(1, 0), cA + kstepA, voffA); PG8_STAGE(PG8_SB(1, 1), cB + hstep + kstepB, voffB);
        PG8_WAIT_V(6); PG8_BAR;
    }
    for (;;) {
        const bool has_next = S.next(ui + 1, nxt);
        const char* nA = has_next ? (const char*)g.A + (size_t)nxt.pm * tstep : cA; const char* nB = has_next ? (const char*)g.Bt + (size_t)nxt.pn * tstep : cB;
        for (int t = 0; t < nt; t += 2) {
            if constexpr (Epi::MIDK > 0) { if (t == Epi::MIDK) E.mid(acc, cur, wr, wc, fr, fq); }
            const bool last = (t == nt - 2);
            const char* a1 = cA + (size_t)(t + 1) * kstepA;
            const char* a2 = last ? nA : cA + (size_t)(t + 2) * kstepA; const char* b2 = last ? nB : cB + (size_t)(t + 2) * kstepB;
            const char* a3 = a2 + kstepA; const char* b3 = b2 + kstepB;
            if (last && has_next) S.a_ready(nxt);
            if constexpr (SP2) {
            PG8_LDB(B0, 0, 0); PG8_LDB(B1, 0, 1); PG8_SCHED; PG8_LDA(At, 0, 0); PG8_STAGE(PG8_SA(1, 1), a1 + hstep, voffA);
            PG8_WAIT_V(8); PG8_WAIT_L(0); PG8_BAR; PG8_MMA(0, 0, At, B0); PG8_MMA(0, 1, At, B1); PG8_BAR; PG8_SCHED;
            PG8_LDA(At, 0, 1); PG8_STAGE(PG8_SB(0, 0), b2, voffB); PG8_STAGE(PG8_SB(0, 1), b2 + hstep, voffB); PG8_STAGE(PG8_SA(0, 0), a2, voffA);
            PG8_WAIT_V(8); PG8_WAIT_L(0); PG8_BAR; PG8_MMA(1, 0, At, B0); PG8_MMA(1, 1, At, B1); PG8_BAR; PG8_SCHED;
            PG8_LDB(B0, 1, 0); PG8_LDB(B1, 1, 1); PG8_SCHED; PG8_LDA(At, 1, 0); PG8_STAGE(PG8_SA(0, 1), a2 + hstep, voffA);
            PG8_WAIT_V(8); PG8_WAIT_L(0); PG8_BAR; PG8_MMA(0, 0, At, B0); PG8_MMA(0, 1, At, B1); PG8_BAR; PG8_SCHED;
            PG8_LDA(At, 1, 1); PG8_STAGE(PG8_SB(1, 0), b3, voffB); PG8_STAGE(PG8_SB(1, 1), b3 + hstep, voffB); PG8_STAGE(PG8_SA(1, 0), a3, voffA);
            PG8_WAIT_V(8); PG8_WAIT_L(0); PG8_BAR; PG8_MMA(1, 0, At, B0); PG8_MMA(1, 1, At, B1); PG8_BAR; PG8_SCHED;
            } else {
            PG8_LDB(B0, 0, 0); PG8_SCHED; PG8_LDA(At, 0, 0); PG8_STAGE(PG8_SA(1, 1), a1 + hstep, voffA);
            PG8_WAIT_L(8); PG8_BAR; PG8_WAIT_L(0); PG8_MMA(0, 0, At, B0); PG8_BAR; PG8_SCHED;
            PG8_LDB(B1, 0, 1); PG8_STAGE(PG8_SB(0, 0), b2, voffB);
            PG8_BAR; PG8_WAIT_L(0); PG8_MMA(0, 1, At, B1); PG8_BAR;
            PG8_LDA(At, 0, 1); PG8_STAGE(PG8_SA(0, 0), a2, voffA);
            PG8_BAR; PG8_WAIT_L(0); PG8_MMA(1, 0, At, B0); PG8_BAR; PG8_SCHED;
            PG8_STAGE(PG8_SB(0, 1), b2 + hstep, voffB);
            PG8_WAIT_V(6); PG8_BAR; PG8_MMA(1, 1, At, B1); PG8_BAR;
            PG8_LDB(B0, 1, 0); PG8_SCHED; PG8_LDA(At, 1, 0); PG8_STAGE(PG8_SA(0, 1), a2 + hstep, voffA);
            PG8_WAIT_L(8); PG8_BAR; PG8_WAIT_L(0); PG8_MMA(0, 0, At, B0); PG8_BAR; PG8_SCHED;
            PG8_LDB(B1, 1, 1); PG8_STAGE(PG8_SB(1, 0), b3, voffB);
            PG8_BAR; PG8_WAIT_L(0); PG8_MMA(0, 1, At, B1); PG8_BAR;
            PG8_LDA(At, 1, 1); PG8_STAGE(PG8_SA(1, 0), a3, voffA);
            PG8_BAR; PG8_WAIT_L(0); PG8_MMA(1, 0, At, B0); PG8_BAR; PG8_SCHED;
            PG8_STAGE(PG8_SB(1, 1), b3 + hstep, voffB);
            PG8_WAIT_V(6); PG8_BAR; PG8_MMA(1, 1, At, B1); PG8_BAR;
            }
        }
        if constexpr (ALIGN_EPI) { if (wr == 0) PG8_BAR; }
        PG8_T0(11);
        if constexpr (!Epi::AFTER_DRAIN) { E(acc, cur, wr, wc, fr, fq); S.done(cur); }
        PG8_T1(11);
        if (!has_next) break;
#pragma unroll
        for (int a = 0; a < 2; ++a)
#pragma unroll
            for (int b = 0; b < 2; ++b)
#pragma unroll
                for (int m = 0; m < 4; ++m)
#pragma unroll
                    for (int n = 0; n < 2; ++n) acc[a][b][m][n] = (f32x4){0.f, 0.f, 0.f, 0.f};
        cur = nxt; cA = nA; cB = nB; ++ui;
        if constexpr (ALIGN_EPI) { if (wr == 1) PG8_BAR; }
    }
    if (PROBE_TK >= 5 && PROBE_TK < 20 && Epi::TAG == PROBE_TAG && wid == PROBE_TW && lane == 0) { PG8_LAS unsigned* tw = (PG8_LAS unsigned*)(lds + 163840 - 128); *tw += (unsigned)tloc_; }
    PG8_WAIT_V(0);
    if constexpr (!ALIGN_EPI) { if (wr == 0) PG8_BAR; }
    PG8_BAR;
    if constexpr (Epi::AFTER_DRAIN) { E.fused(acc, cur, wr, wc, fr, fq, lds, wid, lane); S.done(cur); }
#undef PG8_SA
#undef PG8_SB
#undef PG8_STAGE
#undef PG8_LDA
#undef PG8_LDB
#undef PG8_MMA
#undef PG8_WAIT_V
#undef PG8_WAIT_L
#undef PG8_BAR
#undef PG8_SCHED
#undef PG8_T0
#undef PG8_T1
}
}
#define GAS __attribute__((address_space(1)))
#define LAS __attribute__((address_space(3)))
typedef unsigned short bf16;
typedef unsigned v4u __attribute__((ext_vector_type(4)));
typedef float f32x4 __attribute__((ext_vector_type(4)));
typedef short bf16x8 __attribute__((ext_vector_type(8)));
typedef GAS unsigned gu32;
typedef GAS unsigned long long gu64;
#define RLX_AGENT __ATOMIC_RELAXED, __HIP_MEMORY_SCOPE_AGENT
#define LDS_WAIT() asm volatile("s_waitcnt lgkmcnt(0)" ::: "memory")
#define VM_WAIT() asm volatile("s_waitcnt vmcnt(0)" ::: "memory")
__device__ __forceinline__ unsigned long long rt() { return __builtin_amdgcn_s_memrealtime(); }
__device__ __forceinline__ unsigned f2bf(float f) { unsigned u = __builtin_bit_cast(unsigned, f); return (u + 0x7fffu + ((u >> 16) & 1u)) >> 16; }
__device__ __forceinline__ unsigned pk2(float lo, float hi) { return f2bf(lo) | (f2bf(hi) << 16); }

#define XB_TMO      128
#define XB_XCNT(j)  (256  + 64 * (j))
#define XB_XSUB(j)  (1280 + 64 * (j))
#define XB_XGEN(j)  (2304 + 64 * (j))
#define XB_TOP      3328
#define XB_TOPGEN   3392
#define XCD_BAR_WORDS 3456
#define XB_SPIN_CAP (1u << 18)

__device__ __forceinline__ unsigned xb_ld(unsigned* p)              { return __hip_atomic_load(p, __ATOMIC_RELAXED, __HIP_MEMORY_SCOPE_AGENT); }
__device__ __forceinline__ unsigned xb_add(unsigned* p, unsigned v) { return __hip_atomic_fetch_add(p, v, __ATOMIC_RELAXED, __HIP_MEMORY_SCOPE_AGENT); }
__device__ __forceinline__ unsigned xb_xcc_id() { return (unsigned)__builtin_amdgcn_s_getreg((3 << 11) | 20) & 0xFu; }
#define XB_SPIN(cond, bar) do { unsigned _sp = 0; while (cond) { __builtin_amdgcn_s_sleep(1); \
    if ((++_sp & 255u) == 0u) { if (xb_ld(&(bar)[XB_TMO])) break; if (_sp > XB_SPIN_CAP) { atomicAdd(&(bar)[XB_TMO], 1u); break; } } } } while (0)

struct XcdBarrier {
    unsigned* bar; unsigned x;
    volatile LAS unsigned* st;
};

__device__ __forceinline__ XcdBarrier xcd_barrier_post(unsigned* bar, volatile LAS unsigned* st) {
    XcdBarrier b; b.bar = bar; b.x = xb_xcc_id(); b.st = st;
    if (threadIdx.x == 0) (void)xb_add(&bar[XB_XCNT(b.x)], 1u);
    return b;
}
__device__ __forceinline__ void xcd_barrier_complete(unsigned* bar, unsigned x, unsigned& nloc, unsigned& nx) {
    const unsigned G = gridDim.x * gridDim.y * gridDim.z;
    unsigned sum, cnt, mine, sp = 0u;
    for (;;) {
        sum = 0u; cnt = 0u; mine = 0u;
#pragma unroll
        for (unsigned j = 0; j < 16; ++j) { const unsigned c = xb_ld(&bar[XB_XCNT(j)]); sum += c; cnt += (c > 0u) ? 1u : 0u; mine = (j == x) ? c : mine; }
        if (sum == G) break;
        __builtin_amdgcn_s_sleep(1);
        if ((++sp & 255u) == 0u) { if (xb_ld(&bar[XB_TMO])) break; if (sp > XB_SPIN_CAP) { atomicAdd(&bar[XB_TMO], 1u); break; } }
    }
    nloc = mine > 0u ? mine : 1u; nx = cnt > 0u ? cnt : 1u;
}

__device__ __forceinline__ void xcd_barrier(const XcdBarrier& b) {
    asm volatile("s_waitcnt vmcnt(0)" ::: "memory");
    __syncthreads();
    if (threadIdx.x == 0) {
        unsigned* bar = b.bar;
        __builtin_amdgcn_s_waitcnt(0);
        unsigned nloc = b.st[0], nx = b.st[1];
        if (nloc == 0u) { xcd_barrier_complete(bar, b.x, nloc, nx); b.st[0] = nloc; b.st[1] = nx; }
        const unsigned old = xb_add(&bar[XB_XSUB(b.x)], 1u);
        const unsigned gen = old / nloc;
        if (old + 1u == (gen + 1u) * nloc) {
            __builtin_amdgcn_fence(__ATOMIC_RELEASE, "agent");
            asm volatile("s_waitcnt vmcnt(0)" ::: "memory");
            const unsigned og = xb_add(&bar[XB_TOP], 1u);
            const unsigned tg = og / nx;
            if (og + 1u == (tg + 1u) * nx) xb_add(&bar[XB_TOPGEN], 1u);
            else XB_SPIN(xb_ld(&bar[XB_TOPGEN]) == tg, bar);
            __builtin_amdgcn_fence(__ATOMIC_ACQUIRE, "agent");
            xb_add(&bar[XB_XGEN(b.x)], 1u);
            asm volatile("s_waitcnt vmcnt(0)" ::: "memory");
        } else {
            XB_SPIN(xb_ld(&bar[XB_XGEN(b.x)]) == gen, bar);
            __builtin_amdgcn_fence(__ATOMIC_ACQUIRE, "agent");
            asm volatile("s_waitcnt vmcnt(0)" ::: "memory");
        }
    }
    __syncthreads();
}

constexpr int NWAVES = 8;
constexpr int BATCH = 8, SEQ = 4096, DM = 1024, M = BATCH * SEQ, INW = 6656, FF = 4096;
constexpr int NFREQ = 72;
constexpr float C2 = 0.125f * 1.4426950408889634f;
constexpr float KR_SCALE = 0.08838834764831845f;
constexpr float LAMBDA_INIT = 0.2f;
constexpr int N_PHASES = 8;
#define PROBE_CLK -1
#define PROBE_CLK_E -1
#define PROBE_CLK_DUR 0
#ifndef PROBE_XCC
#define PROBE_XCC 0
#endif
#ifndef PROBE_STAGGER
#define PROBE_STAGGER 0
#endif
#ifndef PROBE_ST2
#define PROBE_ST2 0
#endif
#ifndef MK_N_LAUNCHES
#define MK_N_LAUNCHES 1
#endif

constexpr size_t MiB = 1u << 20;
constexpr size_t WS_CTL = 0, CTL_ZERO_BYTES = 64 * 1024;
constexpr size_t WS_WIN = 2 * MiB, WS_WA = 15 * MiB, WS_WR = 16 * MiB, WS_WO = 18 * MiB, WS_W1 = 20 * MiB, WS_W2 = 28 * MiB;
constexpr size_t WS_CS = 36 * MiB;
constexpr size_t WS_RSS = 54 * MiB;
constexpr size_t WS_MISC = 56 * MiB;
constexpr size_t WS_XN = 64 * MiB;
constexpr size_t WS_QD = 128 * MiB, WS_KD = 160 * MiB, WS_VD = 192 * MiB, WS_QR = 224 * MiB, WS_KR = 256 * MiB;
constexpr size_t WS_VR = 288 * MiB, WS_GS = 352 * MiB;
constexpr size_t WS_OA = 416 * MiB;
constexpr size_t WS_ORR = 448 * MiB;
constexpr size_t WS_TMP = 128 * MiB, WS_MRG = 192 * MiB;
constexpr size_t WS_HID = 128 * MiB;
constexpr size_t WS_ORAW = WS_XN;
constexpr size_t WS_KV = WS_XN;
constexpr size_t WS_ST = WS_QD;
constexpr size_t WS_END = 512 * MiB;
constexpr int CW_BAR = 4096;

constexpr int RING_BYTES = 131072;
constexpr int LDS_BYTES = 163840;
constexpr int MISC_OFF = LDS_BYTES - 256;

struct Frame {
    LAS unsigned char* lds;
    volatile LAS unsigned* MISC;
    gu32* ctl;
    int tid, lane, wave, G;
    unsigned char* ws;
    unsigned long long tacc;
};
struct Args { const void* in[18]; float* out; unsigned char* ws; double invf[NFREQ]; float lg2[4]; int ph_lo, ph_hi, li, pad; };

__device__ __forceinline__ float wave_sum(float v) {
#pragma unroll
    for (int o = 1; o < 64; o <<= 1) v += __shfl_xor(v, o);
    return v;
}
__device__ __forceinline__ float bf2f(unsigned short h) { return __builtin_bit_cast(float, (unsigned)h << 16); }
__device__ __forceinline__ float bflo(unsigned w) { return __builtin_bit_cast(float, w << 16); }
__device__ __forceinline__ float bfhi(unsigned w) { return __builtin_bit_cast(float, w & 0xffff0000u); }

__host__ __device__ __forceinline__ int da_dim(int bj, int i, int fq) {
    if (bj == 0 && i < 4) return (i & 1) + 2 * fq + 8 * (i >> 1);
    const int idx = bj == 0 ? i - 4 : 4 + i; return 16 + 12 * fq + idx;
}
__host__ __device__ __forceinline__ int win_col(int p) {
    const int pn = p >> 8, t = p & 255, bj = t >> 7, wc = (t >> 5) & 3, fq = (t >> 3) & 3, i = t & 7;
    if (pn < 4) { const int G = 4 * (pn & 1) + wc; return (pn >> 1) * 512 + 64 * G + da_dim(bj, i, fq); }
    if (pn >= 6 && pn < 10) { const int head = 2 * (pn & 1) + (wc >> 1); return 1536 + ((pn - 6) >> 1) * 512 + 128 * head + 64 * bj + 32 * (wc & 1) + 8 * fq + i; }
    if (pn >= 18) return 4608 + bj * 1024 + 128 * (pn - 18) + (t & 127);
    return p;
}

template <bool PERMUTE>
__device__ __forceinline__ void p0_transpose_item(const float* W, int K, int N, bf16* WT, LAS float* scr, int item, int lane, const float* kscale, int ldk = 0, int koff = 0, bool blk = false) {
    if (ldk == 0) ldk = K;
    const int nblk = N / 32, kb = item / nblk, nb = item % nblk, k0 = 64 * kb, n0 = 32 * nb;
    const int col = PERMUTE ? win_col(n0 + (lane & 31)) : n0 + (lane & 31);
    if constexpr (PERMUTE) {
        float v[32];
#pragma unroll
        for (int i = 0; i < 32; ++i) v[i] = __builtin_nontemporal_load((const GAS float*)W + (size_t)(k0 + 2 * i + (lane >> 5)) * N + col);
#pragma unroll
        for (int i = 0; i < 32; ++i) { const int kk = 2 * i + (lane >> 5); scr[kk * 33 + (lane & 31)] = kscale ? v[i] * kscale[k0 + kk] : v[i]; }
    } else {
        f32x4 v[8];
#pragma unroll
        for (int i = 0; i < 8; ++i) v[i] = __builtin_nontemporal_load((const GAS f32x4*)(W + (size_t)(k0 + 8 * i + (lane >> 3)) * N + n0 + 4 * (lane & 7)));
#pragma unroll
        for (int i = 0; i < 8; ++i) { const int kk = 8 * i + (lane >> 3); const float ks = kscale ? kscale[k0 + kk] : 1.0f; LAS float* d = scr + kk * 33 + 4 * (lane & 7);
            d[0] = v[i][0] * ks; d[1] = v[i][1] * ks; d[2] = v[i][2] * ks; d[3] = v[i][3] * ks; }
    }
    LDS_WAIT(); asm volatile("" ::: "memory");
    const int c = lane & 7;
#pragma unroll
    for (int j = 0; j < 4; ++j) { const int n = (lane >> 3) + 8 * j; const LAS float* s = scr + (8 * c) * 33 + n;
        v4u o; o.x = pk2(s[0 * 33], s[1 * 33]); o.y = pk2(s[2 * 33], s[3 * 33]); o.z = pk2(s[4 * 33], s[5 * 33]); o.w = pk2(s[6 * 33], s[7 * 33]);
        if (blk) { const int nn = n0 + n, kk = koff + k0 + 8 * c; *(GAS v4u*)(WT + (((size_t)(nn >> 4) * (ldk / 32) + (kk >> 5)) * 512 + ((nn & 15) * 4 + ((kk & 31) >> 3)) * 8)) = o; }
        else *(GAS v4u*)(WT + (size_t)(n0 + n) * ldk + koff + k0 + 8 * c) = o; }
    LDS_WAIT(); asm volatile("" ::: "memory");
}
__device__ __forceinline__ void p0_prologue(Frame& F, const Args& A, int parts = 3) {
    const float* x = (const float*)A.in[0]; const float* n1w = (const float*)A.in[2];
    LAS float* scr = (LAS float*)(F.lds + F.wave * 16384);
    const int gw = blockIdx.x * NWAVES + F.wave, NGW = F.G * NWAVES;
    constexpr int I_IN = (DM / 64) * (INW / 32);
    for (int it = gw; it < I_IN; it += NGW) p0_transpose_item<true>((const float*)A.in[3], DM, INW, (bf16*)(F.ws + WS_WIN), scr, it, F.lane, nullptr);
    bf16* XN = (bf16*)(F.ws + WS_XN);
    f32x4 wv[4];
#pragma unroll
    for (int j = 0; j < 4; ++j) wv[j] = ((const GAS f32x4*)n1w)[128 * (j >> 1) + 2 * F.lane + (j & 1)];
    if (parts & 2) for (int m0 = gw; m0 < M; m0 += 4 * NGW) {
        f32x4 v[4][4];
#pragma unroll
        for (int r = 0; r < 4; ++r) { const int m = m0 + r * NGW < M ? m0 + r * NGW : m0; const GAS f32x4* xr = (const GAS f32x4*)(x + (size_t)m * DM) + 2 * F.lane;
#pragma unroll
            for (int j = 0; j < 2; ++j) { v[r][2 * j] = __builtin_nontemporal_load(xr + 128 * j); v[r][2 * j + 1] = __builtin_nontemporal_load(xr + 128 * j + 1); } }
#pragma unroll
        for (int r = 0; r < 4; ++r) { const int m = m0 + r * NGW; float s = 0.f;
#pragma unroll
            for (int j = 0; j < 4; ++j) s += (v[r][j].x * v[r][j].x + v[r][j].y * v[r][j].y) + (v[r][j].z * v[r][j].z + v[r][j].w * v[r][j].w);
            const float rstd = 1.f / sqrtf(wave_sum(s) * (1.f / DM) + 1e-6f);
            if (m < M) { GAS v4u* o16 = (GAS v4u*)(XN + (size_t)m * DM) + F.lane;
#pragma unroll
                for (int j = 0; j < 2; ++j) { const f32x4 a = v[r][2 * j], b = v[r][2 * j + 1], wa = wv[2 * j], wb = wv[2 * j + 1]; v4u o;
                    o.x = pk2(a.x * rstd * wa.x, a.y * rstd * wa.y); o.y = pk2(a.z * rstd * wa.z, a.w * rstd * wa.w); o.z = pk2(b.x * rstd * wb.x, b.y * rstd * wb.y); o.w = pk2(b.z * rstd * wb.z, b.w * rstd * wb.w);
                    o16[64 * j] = o; } } }
    }
    if (blockIdx.x == 0 && F.wave == 0) {
        const float* qn = (const float*)A.in[4]; const float* kn = (const float*)A.in[5];
        const float* l1q = (const float*)A.in[6]; const float* l1k = (const float*)A.in[7]; const float* l2q = (const float*)A.in[8]; const float* l2k = (const float*)A.in[9];
        const float s1 = wave_sum(l1q[F.lane] * l1k[F.lane]), s2 = wave_sum(l2q[F.lane] * l2k[F.lane]);
        float mq = fabsf(qn[F.lane]), mk = fabsf(kn[F.lane]);
#pragma unroll
        for (int o = 1; o < 64; o <<= 1) { mq = fmaxf(mq, __shfl_xor(mq, o)); mk = fmaxf(mk, __shfl_xor(mk, o)); }
        if (F.lane == 0) { GAS float* misc = (GAS float*)(F.ws + WS_MISC); misc[0] = expf(s1) - expf(s2) + LAMBDA_INIT; misc[1] = 8.0f * 1.4426950408889634f * mq * mk * 1.01f; }
    }
}

__device__ __forceinline__ void p2_weights(Frame& F, const Args& A, int gw_ = -1, int ngw_ = 0) {
    LAS float* scr = (LAS float*)(F.lds + F.wave * 16384);
    constexpr int I_A = (512 / 64) * (DM / 32), I_R = (DM / 64) * (DM / 32), I_O = I_R, I_1 = (DM / 64) * (FF / 32), I_2 = (FF / 64) * (DM / 32), NREST = I_A + I_R + I_O + I_1 + I_2;
    const int gw = gw_ >= 0 ? gw_ : blockIdx.x * NWAVES + F.wave, NGW = gw_ >= 0 ? ngw_ : F.G * NWAVES;
    for (int it = gw; it < NREST; it += NGW) {
        int r = it;
        if (r < I_A) { p0_transpose_item<false>((const float*)A.in[11], 512, DM, (bf16*)(F.ws + WS_WA), scr, r, F.lane, nullptr, 1536, 0, true); continue; } r -= I_A;
        if (r < I_R) { p0_transpose_item<false>((const float*)A.in[13], DM, DM, (bf16*)(F.ws + WS_WA), scr, r, F.lane, nullptr, 1536, 512, true); continue; } r -= I_R;
        if (r < I_O) { p0_transpose_item<false>((const float*)A.in[14], DM, DM, (bf16*)(F.ws + WS_WO), scr, r, F.lane, nullptr); continue; } r -= I_O;
        if (r < I_1) { p0_transpose_item<false>((const float*)A.in[16], DM, FF, (bf16*)(F.ws + WS_W1), scr, r, F.lane, (const float*)A.in[15]); continue; } r -= I_1;
        p0_transpose_item<false>((const float*)A.in[17], FF, DM, (bf16*)(F.ws + WS_W2), scr, r, F.lane, nullptr, 0, 0, true);
    }
}

using pg8::bf16_t; using pg8::Unit; using pg8::cvt_pk_bf16;
typedef unsigned u32x4e __attribute__((ext_vector_type(4)));
__device__ __forceinline__ u32x4e pack8(const f32x4& a, const f32x4& b) { u32x4e w; w.x = cvt_pk_bf16(a[0], a[1]); w.y = cvt_pk_bf16(a[2], a[3]); w.z = cvt_pk_bf16(b[0], b[1]); w.w = cvt_pk_bf16(b[2], b[3]); return w; }
__device__ __forceinline__ float sigmoidf_(float v) { return __builtin_amdgcn_rcpf(1.0f + __builtin_amdgcn_exp2f(-1.4426950408889634f * v)); }

struct EpiProj {
    static constexpr bool PERM = true, AFTER_DRAIN = false, ABLK = false, BBLK = false; static constexpr int MIDK = 0; static constexpr int TAG = 1;
    bf16_t *QD, *KD, *QR, *KR, *GATE; unsigned char* ws; const int* pos; const float* qnw; const float* knw; float lg0, lg1, lg2, lg3;
    __device__ __forceinline__ void operator()(const f32x4 (&acc)[2][2][4][2], const Unit& u, int wr, int wc, int fr_, int fq_) const {
        int fr = fr_, fq = fq_; asm volatile("" : "+v"(fr), "+v"(fq));
        const int pn = u.pn, row0 = u.pm * 256 + wr * 64 + fr;
        if (pn < 4) {
            const bool isq = pn < 2; const float* nw = isq ? qnw : knw; bf16_t* dst = (isq ? QD : KD) + 64 * (4 * (pn & 1) + wc) + 8 * fq;
            const float osc = isq ? C2 : 1.0f;
            float w[2][8];
#pragma unroll
            for (int bj = 0; bj < 2; ++bj)
#pragma unroll
                for (int i = 0; i < 8; ++i) w[bj][i] = ((const GAS float*)nw)[da_dim(bj, i, fq)] * osc;
            const float rda0 = __builtin_amdgcn_exp2f(-(float)(2 * fq) * (18.931568569324174f / 8.0f)) * 0.15915494309189535f, rda1 = __builtin_amdgcn_exp2f(-(float)(2 * fq + 1) * (18.931568569324174f / 8.0f)) * 0.15915494309189535f;
            int pq[2][4];
#pragma unroll
            for (int ai = 0; ai < 2; ++ai)
#pragma unroll
                for (int m = 0; m < 4; ++m) pq[ai][m] = ((const GAS int*)pos)[row0 + ai * 128 + m * 16];
#pragma unroll
            for (int ai = 0; ai < 2; ++ai)
#pragma unroll
                for (int m = 0; m < 4; ++m) {
                    const int row = row0 + ai * 128 + m * 16;
                    f32x4 a0 = acc[ai][0][m][0], a1 = acc[ai][0][m][1], b0 = acc[ai][1][m][0], b1 = acc[ai][1][m][1];
                    float ss = (a0[0] * a0[0] + a0[1] * a0[1]) + (a0[2] * a0[2] + a0[3] * a0[3]) + (a1[0] * a1[0] + a1[1] * a1[1]) + (a1[2] * a1[2] + a1[3] * a1[3])
                             + (b0[0] * b0[0] + b0[1] * b0[1]) + (b0[2] * b0[2] + b0[3] * b0[3]) + (b1[0] * b1[0] + b1[1] * b1[1]) + (b1[2] * b1[2] + b1[3] * b1[3]);
                    ss += __shfl_xor(ss, 16); ss += __shfl_xor(ss, 32);
                    const float rs = __builtin_amdgcn_rsqf(ss * (1.0f / 64.0f) + 1e-6f);
#pragma unroll
                    for (int e = 0; e < 4; ++e) { a0[e] *= rs * w[0][e]; a1[e] *= rs * w[0][4 + e]; b0[e] *= rs * w[1][e]; b1[e] *= rs * w[1][4 + e]; }
                    const float pf = (float)pq[ai][m];
                    const float v0_ = __builtin_amdgcn_fractf(pf * rda0), v1_ = __builtin_amdgcn_fractf(pf * rda1);
                    const float c0 = __builtin_amdgcn_cosf(v0_), s0 = __builtin_amdgcn_sinf(v0_), c1 = __builtin_amdgcn_cosf(v1_), s1 = __builtin_amdgcn_sinf(v1_);
                    { const float t1 = a0[0], t2 = a0[2]; a0[0] = t1 * c0 - t2 * s0; a0[2] = t1 * s0 + t2 * c0; }
                    { const float t1 = a0[1], t2 = a0[3]; a0[1] = t1 * c1 - t2 * s1; a0[3] = t1 * s1 + t2 * c1; }
                    bf16_t* rp = dst + (size_t)row * 512;
                    *(GAS u32x4e*)(rp) = pack8(a0, a1); *(GAS u32x4e*)(rp + 32) = pack8(b0, b1);
                    asm volatile("" ::: "memory");
                }
        } else if (pn >= 6 && pn < 10) {
            const bool isq = pn < 8; const int j0 = 32 * (wc & 1) + 8 * fq;
            bf16_t* dst = (isq ? QR : KR) + 128 * (2 * (pn & 1) + (wc >> 1)) + j0;
            const int head = 2 * (pn & 1) + (wc >> 1); const float lgh = head == 0 ? lg0 : (head == 1 ? lg1 : (head == 2 ? lg2 : lg3));
            const float osc0 = isq ? 1.0f : KR_SCALE, lgs = isq ? lgh : -lgh;
            float rrt[8];
#pragma unroll
            for (int i = 0; i < 8; ++i) rrt[i] = __builtin_amdgcn_exp2f(-(float)(j0 + i) * (13.287712379549449f / 63.0f)) * 0.15915494309189535f;
            int pq[2][4];
#pragma unroll
            for (int ai = 0; ai < 2; ++ai)
#pragma unroll
                for (int m = 0; m < 4; ++m) pq[ai][m] = ((const GAS int*)pos)[row0 + ai * 128 + m * 16];
#pragma unroll
            for (int ai = 0; ai < 2; ++ai)
#pragma unroll
                for (int m = 0; m < 4; ++m) {
                    const int row = row0 + ai * 128 + m * 16;
                    const float pf = (float)pq[ai][m];
                    const float osc = osc0 * __builtin_amdgcn_exp2f(lgs * (float)(row & 127));
                    f32x4 t1[2] = {acc[ai][0][m][0], acc[ai][0][m][1]}, t2[2] = {acc[ai][1][m][0], acc[ai][1][m][1]}, o1[2], o2[2];
#pragma unroll
                    for (int n = 0; n < 2; ++n)
#pragma unroll
                        for (int e = 0; e < 4; ++e) { const float rv = __builtin_amdgcn_fractf(pf * rrt[4 * n + e]); const float cc = __builtin_amdgcn_cosf(rv) * osc, ss = __builtin_amdgcn_sinf(rv) * osc;
                            o1[n][e] = t1[n][e] * cc - t2[n][e] * ss; o2[n][e] = t1[n][e] * ss + t2[n][e] * cc; }
                    const size_t eo = (((size_t)(row >> 4) * 16 + head * 4 + (wc & 1)) * 512 + ((row & 15) * 4 + fq) * 8) - (size_t)(128 * head + j0);
                    bf16_t* rp = dst + eo;
                    *(GAS u32x4e*)(rp) = pack8(o1[0], o1[1]); *(GAS u32x4e*)(rp + 2 * 512) = pack8(o2[0], o2[1]);
                    asm volatile("" ::: "memory");
                }
        } else if (pn >= 18) {
            bf16_t* dst = GATE + 128 * (pn - 18) + wc * 32 + 8 * fq;
#pragma unroll
            for (int ai = 0; ai < 2; ++ai)
#pragma unroll
                for (int m = 0; m < 4; ++m) {
                    const int row = row0 + ai * 128 + m * 16; bf16_t* rp = dst + (size_t)row * 2048;
                    f32x4 g0 = acc[ai][0][m][0], g1 = acc[ai][0][m][1], r0 = acc[ai][1][m][0], r1 = acc[ai][1][m][1];
#pragma unroll
                    for (int e = 0; e < 4; ++e) {
                        const float ea = __builtin_amdgcn_exp2f(-1.4426950408889634f * fmaxf(r0[e], -30.0f)), eb = __builtin_amdgcn_exp2f(-1.4426950408889634f * fmaxf(r1[e], -30.0f));
                        g0[e] = sigmoidf_(g0[e]) * (1.0f + ea); g1[e] = sigmoidf_(g1[e]) * (1.0f + eb);
                        r0[e] = __builtin_amdgcn_rcpf(1.0f + ea); r1[e] = __builtin_amdgcn_rcpf(1.0f + eb); }
                    *(GAS u32x4e*)(rp) = pack8(g0, g1); *(GAS u32x4e*)(rp + 1024) = pack8(r0, r1);
                    asm volatile("" ::: "memory");
                }
        } else {
            const int act = pn < 14 ? 0 : (pn < 18 ? 1 : 2);
            const int ld = pn < 6 ? 512 : (pn < 18 ? 1024 : 2048);
            const int colt = (pn < 6 ? pn - 4 : (pn < 14 ? pn - 10 : (pn < 18 ? pn - 14 : pn - 18))) * 256;
            const size_t woff = pn < 6 ? WS_VD : (pn < 14 ? WS_VR : WS_GS);
            bf16_t* dst = (pn < 18 ? (bf16_t*)(ws + woff) : GATE) + colt + wc * 32 + 8 * fq;
            const bool vblk = pn >= 10 && pn < 14; const int vcb = (pn - 10) * 8 + wc;
#pragma unroll
            for (int ai = 0; ai < 2; ++ai)
#pragma unroll
                for (int m = 0; m < 4; ++m) {
                    const int row = row0 + ai * 128 + m * 16;
#pragma unroll
                    for (int bj = 0; bj < 2; ++bj) { f32x4 v0 = acc[ai][bj][m][0], v1 = acc[ai][bj][m][1];
                        if (act) {
#pragma unroll
                            for (int e = 0; e < 4; ++e) { const float s0 = sigmoidf_(v0[e]), s1 = sigmoidf_(v1[e]); v0[e] = act == 1 ? v0[e] * s0 : s0; v1[e] = act == 1 ? v1[e] * s1 : s1; } }
                        const size_t eo = vblk ? (((size_t)(row >> 4) * 32 + vcb + bj * 4) * 512 + ((row & 15) * 4 + fq) * 8) - (size_t)(colt + wc * 32 + 8 * fq) : (size_t)row * ld + bj * 128;
                        *(GAS u32x4e*)(dst + eo) = pack8(v0, v1); }
                    asm volatile("" ::: "memory");
                }
        }
    }
};
struct EpiMerge2 {
    static constexpr bool PERM = true, AFTER_DRAIN = false, ABLK = true, BBLK = true; static constexpr int MIDK = 8; static constexpr int TAG = 5;
    const bf16_t* GATE; bf16_t* MRG;
    template <int HALF> __device__ __forceinline__ void scale(f32x4 (&acc)[2][2][4][2], const Unit& u, int wr, int wc, int fr_, int fq_) const {
        int fr = fr_, fq = fq_; asm volatile("" : "+v"(fr), "+v"(fq));
        const int row0 = u.pm * 256 + wr * 64 + fr, col0 = u.pn * 256 + wc * 32 + 8 * fq;
        u32x4e gq[2][4][2];
#pragma unroll
        for (int ai = 0; ai < 2; ++ai)
#pragma unroll
            for (int m = 0; m < 4; ++m)
#pragma unroll
                for (int bj = 0; bj < 2; ++bj) gq[ai][m][bj] = *(const GAS u32x4e*)(GATE + (size_t)(row0 + ai * 128 + m * 16) * 2048 + HALF * 1024 + col0 + bj * 128);
#pragma unroll
        for (int ai = 0; ai < 2; ++ai)
#pragma unroll
            for (int m = 0; m < 4; ++m) { const size_t row = (size_t)(row0 + ai * 128 + m * 16);
#pragma unroll
                for (int bj = 0; bj < 2; ++bj) { const int col = col0 + bj * 128;
                    const u32x4e g = gq[ai][m][bj];
                    f32x4& v0 = acc[ai][bj][m][0]; f32x4& v1 = acc[ai][bj][m][1];
                    v0[0] *= bflo(g.x); v0[1] *= bfhi(g.x); v0[2] *= bflo(g.y); v0[3] *= bfhi(g.y); v1[0] *= bflo(g.z); v1[1] *= bfhi(g.z); v1[2] *= bflo(g.w); v1[3] *= bfhi(g.w);
                    if (HALF == 1) *(GAS u32x4e*)(MRG + row * 1024 + col) = pack8(v0, v1); } }
    }
    __device__ __forceinline__ void mid(f32x4 (&acc)[2][2][4][2], const Unit& u, int wr, int wc, int fr, int fq) const { scale<0>(acc, u, wr, wc, fr, fq); }
    __device__ __forceinline__ void operator()(const f32x4 (&acc)[2][2][4][2], const Unit& u, int wr, int wc, int fr, int fq) const {
        f32x4 (&a)[2][2][4][2] = const_cast<f32x4 (&)[2][2][4][2]>(acc); scale<1>(a, u, wr, wc, fr, fq); }
};
struct EpiX1 {
    static constexpr bool PERM = true, AFTER_DRAIN = false, ABLK = false, BBLK = false; static constexpr int MIDK = 0; static constexpr int TAG = 6;
    const float* x; float* out; bf16_t* XN; float* rss;
    __device__ __forceinline__ void operator()(const f32x4 (&acc)[2][2][4][2], const Unit& u, int wr, int wc, int fr_, int fq_) const {
        int fr = fr_, fq = fq_; asm volatile("" : "+v"(fr), "+v"(fq));
        const int row0 = u.pm * 256 + wr * 64 + fr, col0 = u.pn * 256 + wc * 32 + 8 * fq;
#pragma unroll
        for (int ai = 0; ai < 2; ++ai) {
            f32x4 xq[4][2][2];
#pragma unroll
            for (int m = 0; m < 4; ++m)
#pragma unroll
                for (int bj = 0; bj < 2; ++bj) { const size_t off = (size_t)(row0 + ai * 128 + m * 16) * 1024 + col0 + bj * 128; xq[m][bj][0] = *(const GAS f32x4*)(x + off); xq[m][bj][1] = *(const GAS f32x4*)(x + off + 4); }
#pragma unroll
            for (int m = 0; m < 4; ++m) { const size_t row = (size_t)(row0 + ai * 128 + m * 16); float ss = 0.f;
#pragma unroll
                for (int bj = 0; bj < 2; ++bj) { const size_t off = row * 1024 + col0 + bj * 128;
                    const f32x4 v0 = acc[ai][bj][m][0] + xq[m][bj][0], v1 = acc[ai][bj][m][1] + xq[m][bj][1];
                    *(GAS u32x4e*)(XN + off) = pack8(v0, v1);
                    ss += (v0[0] * v0[0] + v0[1] * v0[1]) + (v0[2] * v0[2] + v0[3] * v0[3]) + (v1[0] * v1[0] + v1[1] * v1[1]) + (v1[2] * v1[2] + v1[3] * v1[3]); }
                ss += __shfl_xor(ss, 16); ss += __shfl_xor(ss, 32);
                if (fq == 0) ((GAS float*)rss)[row * 16 + u.pn * 4 + wc] = ss; }
        }
    }
};
struct EpiHid {
    static constexpr bool PERM = true, AFTER_DRAIN = false, ABLK = false, BBLK = false; static constexpr int MIDK = 0; static constexpr int TAG = 7;
    const float* rss; bf16_t* HID;
    __device__ __forceinline__ void operator()(const f32x4 (&acc)[2][2][4][2], const Unit& u, int wr, int wc, int fr_, int fq_) const {
        int fr = fr_, fq = fq_; asm volatile("" : "+v"(fr), "+v"(fq));
        const int row0 = u.pm * 256 + wr * 64 + fr, col0 = u.pn * 256 + wc * 32 + 8 * fq;
        f32x4 rq[2][4];
#pragma unroll
        for (int ai = 0; ai < 2; ++ai)
#pragma unroll
            for (int m = 0; m < 4; ++m) rq[ai][m] = *((const GAS f32x4*)(rss + (size_t)(row0 + ai * 128 + m * 16) * 16) + fq);
#pragma unroll
        for (int ai = 0; ai < 2; ++ai)
#pragma unroll
            for (int m = 0; m < 4; ++m) { const size_t row = (size_t)(row0 + ai * 128 + m * 16);
                const f32x4 r0 = rq[ai][m];
                float ssum = (r0[0] + r0[1]) + (r0[2] + r0[3]); ssum += __shfl_xor(ssum, 16); ssum += __shfl_xor(ssum, 32);
                const float rs = __builtin_amdgcn_rsqf(ssum * (1.0f / 1024.0f) + 1e-6f);
#pragma unroll
                for (int bj = 0; bj < 2; ++bj) { f32x4 v0 = acc[ai][bj][m][0] * rs, v1 = acc[ai][bj][m][1] * rs;
#pragma unroll
                    for (int e = 0; e < 4; ++e) { const float a = fmaxf(v0[e], 0.f), b = fmaxf(v1[e], 0.f); v0[e] = a * a; v1[e] = b * b; }
                    *(GAS u32x4e*)(HID + (((row >> 4) * (4096 / 32) + ((col0 + bj * 128) >> 5)) * 512 + ((row & 15) * 4 + fq) * 8)) = pack8(v0, v1); } }
    }
};
struct RevOrder : pg8::StaticOrder {
    __device__ __forceinline__ bool next(int i, pg8::Unit& u) const { const bool ok = pg8::StaticOrder::next(i, u); u.pm = nM - 1 - u.pm; return ok; }
};
struct P1Order : pg8::StaticOrder {
    __device__ __forceinline__ bool next(int i, pg8::Unit& u) const { const bool ok = pg8::StaticOrder::next(i, u); u.pn = u.pn < 8 ? u.pn + 18 : u.pn - 8; return ok; }
};
struct EpiOut {
    static constexpr bool PERM = true, AFTER_DRAIN = false, ABLK = true, BBLK = true; static constexpr int MIDK = 0; static constexpr int TAG = 8;
    float* out; const bf16_t* XN;
    __device__ __forceinline__ void operator()(const f32x4 (&acc)[2][2][4][2], const Unit& u, int wr, int wc, int fr_, int fq_) const {
        int fr = fr_, fq = fq_; asm volatile("" : "+v"(fr), "+v"(fq));
        const int row0 = u.pm * 256 + wr * 64 + fr, col0 = u.pn * 256 + wc * 32 + 8 * fq;
        u32x4e xq[2][4][2];
#pragma unroll
        for (int ai = 0; ai < 2; ++ai)
#pragma unroll
            for (int m = 0; m < 4; ++m)
#pragma unroll
                for (int bj = 0; bj < 2; ++bj) xq[ai][m][bj] = *(const GAS u32x4e*)(XN + (size_t)(row0 + ai * 128 + m * 16) * 1024 + col0 + bj * 128);
#pragma unroll
        for (int ai = 0; ai < 2; ++ai)
#pragma unroll
            for (int m = 0; m < 4; ++m) { const size_t row = (size_t)(row0 + ai * 128 + m * 16);
#pragma unroll
                for (int bj = 0; bj < 2; ++bj) { float* p = out + row * 1024 + col0 + bj * 128; const u32x4e xr = xq[ai][m][bj];
                    f32x4 v0 = acc[ai][bj][m][0], v1 = acc[ai][bj][m][1];
                    v0[0] += bflo(xr.x); v0[1] += bfhi(xr.x); v0[2] += bflo(xr.y); v0[3] += bfhi(xr.y); v1[0] += bflo(xr.z); v1[1] += bfhi(xr.z); v1[2] += bflo(xr.w); v1[3] += bfhi(xr.w);
                    *(GAS f32x4*)(p) = v0; *(GAS f32x4*)(p + 4) = v1; } }
    }
};


namespace da {
typedef short bf16x8 __attribute__((ext_vector_type(8)));
typedef short s16x4 __attribute__((ext_vector_type(4)));
typedef float f32x16 __attribute__((ext_vector_type(16)));
typedef unsigned u32x4 __attribute__((ext_vector_type(4)));
typedef __attribute__((address_space(3))) const unsigned char* lds_cptr;
constexpr int SLOT = 32768, VOFF = 16384;
__device__ __forceinline__ int crow(int r, int hi) { return (r & 3) + 8 * (r >> 2) + 4 * hi; }
__device__ __forceinline__ void glds16(const void* gsrc, unsigned lds_dst) { unsigned keep;
    asm volatile("s_mov_b32 %0, m0\n\ts_mov_b32 m0, %2\n\ts_nop 0\n\tglobal_load_lds_dwordx4 %1, off\n\ts_mov_b32 m0, %0" : "=&s"(keep) : "v"(gsrc), "s"(lds_dst) : "memory"); }
typedef float f32x2_t __attribute__((ext_vector_type(2))); typedef __bf16 bf16x2_t __attribute__((ext_vector_type(2)));
__device__ __forceinline__ unsigned cvtpk(float lo, float hi) { f32x2_t v = {lo, hi}; bf16x2_t b = __builtin_convertvector(v, bf16x2_t); return __builtin_bit_cast(unsigned, b); }
typedef short v4i16_t __attribute__((ext_vector_type(4)));
__device__ __forceinline__ s16x4 vtr(lds_cptr p) { return __builtin_bit_cast(s16x4, __builtin_amdgcn_ds_read_tr16_b64_v4i16((__attribute__((address_space(3))) v4i16_t*)p)); }
#define DA_MFMA(a, b, c) __builtin_amdgcn_mfma_f32_32x32x16_bf16(a, b, c, 0, 0, 0)
#define DA_WAIT_BAR(N) asm volatile("s_waitcnt vmcnt(" #N ") lgkmcnt(0)\n\ts_barrier" ::: "memory")

#define DA_SB() __builtin_amdgcn_sched_barrier(0)
#define DA_PIN(x) asm volatile("" : "+v"(x))
#define DA_EX(S, A, r) do { S[r] = __builtin_amdgcn_exp2f(S[r]); A += S[r]; } while (0)
typedef const __attribute__((address_space(3))) bf16x8* lds_frag_ptr;
__device__ __forceinline__ void half_step(unsigned ka0, unsigned va0, unsigned va1, const bf16x8 (&q0)[4], const bf16x8 (&q1)[4], f32x16 (&O0)[4], f32x16 (&O1)[4], float& l0, float& l1, bool diag, int r32, int hi) {
#define DA_LDK(c, d0) (*(lds_frag_ptr)(size_t)(ka0 ^ (unsigned)((8 * (c) + 2 * (d0)) << 4)))
#define DA_VF(n) const s16x4 vl##n = vtr((lds_cptr)(size_t)((va0 + ((n) >> 2) * 4096) ^ (unsigned)(((n) & 3) << 6))), vh##n = vtr((lds_cptr)(size_t)((va1 + ((n) >> 2) * 4096) ^ (unsigned)(((n) & 3) << 6)))
#define DA_VFR(n) ((bf16x8){vl##n[0], vl##n[1], vl##n[2], vl##n[3], vh##n[0], vh##n[1], vh##n[2], vh##n[3]})
    f32x16 s0 = {}, s1 = {}; float a0 = 0.f, a1 = 0.f; u32x4 w00, w01, w10, w11;
    { const bf16x8 ka = DA_LDK(0, 0), kb = DA_LDK(0, 1), kc = DA_LDK(0, 2), kd = DA_LDK(0, 3); DA_SB();
      s0 = DA_MFMA(ka, q0[0], s0); s0 = DA_MFMA(kb, q0[1], s0); s0 = DA_MFMA(kc, q0[2], s0); s0 = DA_MFMA(kd, q0[3], s0); }
    const bf16x8 ke = DA_LDK(1, 0), kf = DA_LDK(1, 1), kg = DA_LDK(1, 2), kh_ = DA_LDK(1, 3);
    DA_SB();
    if (diag) {
#pragma unroll
        for (int r = 0; r < 16; ++r) { if (crow(r, hi) > r32) s0[r] = -INFINITY; }
    }
    DA_SB();
    s1 = DA_MFMA(ke, q1[0], s1); DA_EX(s0, a0, 0); DA_EX(s0, a0, 1); DA_PIN(s0); DA_PIN(a0); DA_SB();
    s1 = DA_MFMA(kf, q1[1], s1); DA_EX(s0, a0, 2); DA_EX(s0, a0, 3); w00.x = cvtpk(s0[0], s0[1]); w00.y = cvtpk(s0[2], s0[3]); DA_PIN(s0); DA_PIN(a0); DA_PIN(w00); DA_SB();
    DA_VF(0); DA_VF(1);
    s1 = DA_MFMA(kg, q1[2], s1); DA_EX(s0, a0, 4); DA_EX(s0, a0, 5); DA_PIN(s0); DA_PIN(a0); DA_SB();
    DA_VF(2); DA_VF(3);
    s1 = DA_MFMA(kh_, q1[3], s1); DA_EX(s0, a0, 6); DA_EX(s0, a0, 7); w00.z = cvtpk(s0[4], s0[5]); w00.w = cvtpk(s0[6], s0[7]); DA_PIN(s0); DA_PIN(a0); DA_PIN(w00); DA_SB();
    if (diag) {
#pragma unroll
        for (int r = 0; r < 16; ++r) { if (crow(r, hi) > r32) s1[r] = -INFINITY; }
    }
    DA_SB();
    const bf16x8 pa00 = __builtin_bit_cast(bf16x8, w00);
    O0[0] = DA_MFMA(pa00, DA_VFR(0), O0[0]); DA_EX(s1, a1, 0); DA_EX(s1, a1, 1); DA_PIN(s1); DA_PIN(a1); DA_SB();
    O0[1] = DA_MFMA(pa00, DA_VFR(1), O0[1]); DA_EX(s1, a1, 2); DA_EX(s1, a1, 3); w10.x = cvtpk(s1[0], s1[1]); w10.y = cvtpk(s1[2], s1[3]); DA_PIN(s1); DA_PIN(a1); DA_PIN(w10); DA_SB();
    O0[2] = DA_MFMA(pa00, DA_VFR(2), O0[2]); DA_EX(s1, a1, 4); DA_EX(s1, a1, 5); DA_PIN(s1); DA_PIN(a1); DA_SB();
    O0[3] = DA_MFMA(pa00, DA_VFR(3), O0[3]); DA_EX(s1, a1, 6); DA_EX(s1, a1, 7); w10.z = cvtpk(s1[4], s1[5]); w10.w = cvtpk(s1[6], s1[7]); DA_PIN(s1); DA_PIN(a1); DA_PIN(w10); DA_SB();
    const bf16x8 pa10 = __builtin_bit_cast(bf16x8, w10);
    O1[0] = DA_MFMA(pa10, DA_VFR(0), O1[0]); DA_EX(s0, a0, 8); DA_EX(s0, a0, 9); DA_PIN(s0); DA_PIN(a0); DA_SB();
    O1[1] = DA_MFMA(pa10, DA_VFR(1), O1[1]); DA_EX(s0, a0, 10); DA_EX(s0, a0, 11); w01.x = cvtpk(s0[8], s0[9]); w01.y = cvtpk(s0[10], s0[11]); DA_PIN(s0); DA_PIN(a0); DA_PIN(w01); DA_SB();
    DA_VF(4); DA_VF(5);
    O1[2] = DA_MFMA(pa10, DA_VFR(2), O1[2]); DA_EX(s0, a0, 12); DA_EX(s0, a0, 13); DA_PIN(s0); DA_PIN(a0); DA_SB();
    DA_VF(6); DA_VF(7);
    O1[3] = DA_MFMA(pa10, DA_VFR(3), O1[3]); DA_EX(s0, a0, 14); DA_EX(s0, a0, 15); w01.z = cvtpk(s0[12], s0[13]); w01.w = cvtpk(s0[14], s0[15]); DA_PIN(a0); DA_PIN(w01); DA_SB();
    const bf16x8 pa01 = __builtin_bit_cast(bf16x8, w01);
    O0[0] = DA_MFMA(pa01, DA_VFR(4), O0[0]); DA_EX(s1, a1, 8); DA_EX(s1, a1, 9); DA_PIN(s1); DA_PIN(a1); DA_SB();
    O0[1] = DA_MFMA(pa01, DA_VFR(5), O0[1]); DA_EX(s1, a1, 10); DA_EX(s1, a1, 11); w11.x = cvtpk(s1[8], s1[9]); w11.y = cvtpk(s1[10], s1[11]); DA_PIN(s1); DA_PIN(a1); DA_PIN(w11); DA_SB();
    O0[2] = DA_MFMA(pa01, DA_VFR(6), O0[2]); DA_EX(s1, a1, 12); DA_EX(s1, a1, 13); DA_PIN(s1); DA_PIN(a1); DA_SB();
    O0[3] = DA_MFMA(pa01, DA_VFR(7), O0[3]); DA_EX(s1, a1, 14); DA_EX(s1, a1, 15); w11.z = cvtpk(s1[12], s1[13]); w11.w = cvtpk(s1[14], s1[15]); DA_PIN(a1); DA_PIN(w11); DA_SB();
    const bf16x8 pa11 = __builtin_bit_cast(bf16x8, w11);
    O1[0] = DA_MFMA(pa11, DA_VFR(4), O1[0]); O1[1] = DA_MFMA(pa11, DA_VFR(5), O1[1]); O1[2] = DA_MFMA(pa11, DA_VFR(6), O1[2]); O1[3] = DA_MFMA(pa11, DA_VFR(7), O1[3]);
    l0 += a0; l1 += a1;
    DA_SB();
#undef DA_LDK
#undef DA_VF
#undef DA_VFR
}

__device__ __forceinline__ void attn_unit(int b, int h, int qb, const unsigned short* QD, const unsigned short* KD, const unsigned short* VD, unsigned short* OA, const float* subw, float lam,
                                          __attribute__((address_space(3))) unsigned char* shm, unsigned long long& tacc) {
#define DA_T0(k) unsigned long long tt_##k = 0; if (PROBE_TK == (k) && wid == PROBE_TW) tt_##k = __builtin_amdgcn_s_memrealtime()
#define DA_T1(k) if (PROBE_TK == (k) && wid == PROBE_TW) tacc += __builtin_amdgcn_s_memrealtime() - tt_##k
    int tid = threadIdx.x; asm volatile("" : "+v"(tid));
    const int lane = tid & 63, r32 = lane & 31, hi = lane >> 5; const int wid = __builtin_amdgcn_readfirstlane(tid >> 6);
    const size_t tok0 = (size_t)b * SEQ; const int q0 = qb * 256;
    const unsigned lds0 = (unsigned)(uintptr_t)shm;
    const int l4 = lane >> 4, rloc = 4 * wid + l4;
    const unsigned short* ksrc = KD + (tok0 + rloc) * 512 + h * 128 + ((lane & 15) ^ (rloc & 15)) * 8;
    const unsigned short* vsrc = VD + (tok0 + rloc) * 512 + h * 128 + ((lane & 15) ^ ((l4 << 2) | (wid & 3))) * 8;
    const unsigned kdst = lds0 + wid * 1024, vdst = lds0 + VOFF + wid * 1024;
#define DA_DMA(t, slot) do { const size_t o_ = (size_t)(t) * 64 * 512; \
        glds16(ksrc + o_, (unsigned)__builtin_amdgcn_readfirstlane(kdst + (slot))); glds16(ksrc + o_ + 32 * 512, (unsigned)__builtin_amdgcn_readfirstlane(kdst + (slot) + 8192)); \
        glds16(vsrc + o_, (unsigned)__builtin_amdgcn_readfirstlane(vdst + (slot))); glds16(vsrc + o_ + 32 * 512, (unsigned)__builtin_amdgcn_readfirstlane(vdst + (slot) + 8192)); } while (0)
    const int NT = 4 * (qb + 1);
    DA_DMA(0, 0); DA_DMA(1, SLOT); DA_DMA(2, 2 * SLOT);
    bf16x8 q0f[4], q1f[4];
    { const unsigned short* qp = QD + (tok0 + q0 + wid * 32 + r32) * 512 + h * 128 + hi * 8;
#pragma unroll
      for (int d0 = 0; d0 < 4; ++d0) { q0f[d0] = *(const GAS bf16x8*)(qp + d0 * 16); q1f[d0] = *(const GAS bf16x8*)(qp + 64 + d0 * 16); } }
    asm volatile("" :: "v"(q0f[0]), "v"(q0f[1]), "v"(q0f[2]), "v"(q0f[3]), "v"(q1f[0]), "v"(q1f[1]), "v"(q1f[2]), "v"(q1f[3]));
    f32x16 O0[4], O1[4];
#pragma unroll
    for (int i = 0; i < 4; ++i) { O0[i] = f32x16{}; O1[i] = f32x16{}; }
    float l0 = 0.f, l1 = 0.f;
    const unsigned kab = lds0 + r32 * 256 + (((r32 & 15) ^ hi) << 4);
    unsigned vab[2];
    { const int q = (lane & 15) >> 2, p = lane & 3, g1 = (lane >> 4) & 1;
#pragma unroll
      for (int sec = 0; sec < 2; ++sec) vab[sec] = lds0 + VOFF + (4 * hi + q) * 256 + 64 * q + 16 * ((2 * g1 + (p >> 1)) ^ ((hi + 2 * sec) & 3)) + 8 * (p & 1) + sec * 2048; }
    const int HB = 2 * NT - 8;
    int slot = -SLOT, slot2 = 2 * SLOT;
    for (int hs = 0; hs < 2 * NT; ++hs) {
        const int t = hs >> 1;
        if ((hs & 1) == 0) {
            { DA_T0(1);
            if (t + 2 < NT) { DA_WAIT_BAR(8); } else if (t + 1 < NT) { DA_WAIT_BAR(4); } else { DA_WAIT_BAR(0); }
            DA_T1(1); }
            slot = slot == 3 * SLOT ? 0 : slot + SLOT; slot2 = slot2 == 3 * SLOT ? 0 : slot2 + SLOT;
            { DA_T0(2);
            if (wid < 4 && t + 3 < NT) DA_DMA(t + 3, slot2);
            DA_T1(2); }
        } else { DA_T0(2); if (wid >= 4 && t + 3 < NT) DA_DMA(t + 3, slot2); DA_T1(2); }
        const int rel = hs - HB - wid;
        if (rel <= 0) { const unsigned ho = (unsigned)(slot + (hs & 1) * 8192);
            DA_T0(3);
            half_step(kab + ho, vab[0] + ho, vab[1] + ho, q0f, q1f, O0, O1, l0, l1, rel == 0, r32, hi);
            DA_T1(3); }
    }
    DA_T0(4);
    l0 += __shfl_xor(l0, 32); l1 += __shfl_xor(l1, 32);
    asm volatile("s_waitcnt lgkmcnt(0)\n\ts_barrier" ::: "memory");
    __attribute__((address_space(3))) float* lw = (__attribute__((address_space(3))) float*)(shm + 65536) + wid * 64;
    if (hi == 0) { lw[r32] = __builtin_amdgcn_rcpf(l0); lw[32 + r32] = lam * __builtin_amdgcn_rcpf(l1); }
    asm volatile("s_waitcnt lgkmcnt(0)" ::: "memory");
    __attribute__((address_space(3))) unsigned short* stg = (__attribute__((address_space(3))) unsigned short*)(shm + wid * 8192);
    float sw[4];
#pragma unroll
    for (int db = 0; db < 4; ++db) sw[db] = ((const GAS float*)subw)[db * 32 + r32];
    float ssq[16];
#pragma unroll
    for (int r = 0; r < 16; ++r) { const float i0 = lw[crow(r, hi)], i1 = lw[32 + crow(r, hi)]; float s = 0.f;
#pragma unroll
        for (int db = 0; db < 4; ++db) { const float o = O0[db][r] * i0 - O1[db][r] * i1; O0[db][r] = o; s += o * o; }
        ssq[r] = s; }
#pragma unroll
    for (int o = 1; o < 32; o <<= 1) {
#pragma unroll
        for (int r = 0; r < 16; ++r) ssq[r] += __shfl_xor(ssq[r], o); }
#pragma unroll
    for (int r = 0; r < 16; ++r) { const float rs = (1.0f - LAMBDA_INIT) * __builtin_amdgcn_rsqf(ssq[r] * (1.0f / 128.0f) + 1e-5f); const int row = crow(r, hi);
#pragma unroll
        for (int db = 0; db < 4; ++db) stg[row * 128 + (db ^ (r & 3)) * 32 + r32] = (unsigned short)cvtpk(O0[db][r] * rs * sw[db], 0.f); }
    asm volatile("s_waitcnt lgkmcnt(0)" ::: "memory");
    unsigned short* Ow = OA + ((size_t)(((tok0 + q0 + wid * 32) >> 4) * 48 + 4 * h)) * 512 + lane * 8;
    const int lrow = lane >> 2, lsw = (lrow & 3) * 32 + (lane & 3) * 8;
#pragma unroll
    for (int i = 0; i < 8; ++i) { const int rbk = i >> 2, cb = i & 3;
        const u32x4 v = *(const __attribute__((address_space(3))) u32x4*)(stg + (rbk * 16 + lrow) * 128 + (lsw ^ (cb * 32)));
        *(GAS u32x4*)(Ow + (rbk * 48 + cb) * 512) = v; }
    asm volatile("s_waitcnt lgkmcnt(0)\n\ts_barrier" ::: "memory");
    DA_T1(4);
#undef DA_DMA
#undef DA_T0
#undef DA_T1
}
#undef DA_MFMA
#undef DA_WAIT_BAR
#undef DA_SB
#undef DA_PIN
#undef DA_EX
}

__device__ __forceinline__ void attn_phase(Frame& F, const Args& A) {
    const unsigned short* QD = (const unsigned short*)(F.ws + WS_QD); const unsigned short* KD = (const unsigned short*)(F.ws + WS_KD); const unsigned short* VD = (const unsigned short*)(F.ws + WS_VD);
    unsigned short* OA = (unsigned short*)(F.ws + WS_OA);
    const float lam = ((const GAS float*)(F.ws + WS_MISC))[0]; const float* subw = (const float*)A.in[10];
    const int bx = blockIdx.x, G = F.G;
    for (int it0 = (G % 8 == 0) ? (bx % 8) * (G / 8) + bx / 8 : bx; it0 < 256; it0 += G) {
        const int bh = it0 >> 3, s = it0 & 7, b = bh >> 2, h = bh & 3;
        for (int u = 0; u < 2; ++u) da::attn_unit(b, h, u == 0 ? 15 - s : s, QD, KD, VD, OA, subw, lam, F.lds, F.tacc);
    }
}


namespace rtn {
using da::bf16x8; using da::s16x4; using da::f32x16; using da::u32x4; using da::lds_cptr; using da::glds16; using da::cvtpk; using da::vtr; using da::crow;
#define RT_MFMA(a, b, c) __builtin_amdgcn_mfma_f32_32x32x16_bf16(a, b, c, 0, 0, 0)
#define RT_SB() __builtin_amdgcn_sched_barrier(0)
constexpr int KIMG = 0, VIMG = 32768, STATS = 98304;

__device__ __forceinline__ void dma_v(const unsigned short* VR, size_t tok0, int h, int wid, int lane, unsigned lds0) {
    const unsigned short* src = VR + (((size_t)(tok0 >> 4) + wid) * 32 + h * 8) * 512 + lane * 8;
#pragma unroll
    for (int i = 0; i < 8; ++i) glds16(src + i * 512, (unsigned)__builtin_amdgcn_readfirstlane(lds0 + VIMG + i * 8192 + wid * 1024));
}

__device__ __forceinline__ void stage_a_item(int item, const unsigned short* KR, const unsigned short* VR, unsigned short* KV, __attribute__((address_space(3))) unsigned char* shm) {
    int tid = threadIdx.x; asm volatile("" : "+v"(tid));
    const int lane = tid & 63, hi = lane >> 5; const int wid = __builtin_amdgcn_readfirstlane(tid >> 6);
    const int j = item & 31, bh = item >> 5, h = bh & 3, b = bh >> 2;
    const size_t tok0 = (size_t)b * SEQ + j * 128;
    const unsigned lds0 = (unsigned)(uintptr_t)shm;
    { const unsigned short* src = KR + (((tok0 >> 4) + wid) * 16 + h * 4) * 512 + lane * 8;
#pragma unroll
      for (int i = 0; i < 4; ++i) glds16(src + i * 512, (unsigned)__builtin_amdgcn_readfirstlane(lds0 + KIMG + i * 8192 + wid * 1024)); }
    dma_v(VR, tok0, h, wid, lane, lds0);
    asm volatile("s_waitcnt vmcnt(0)\n\ts_barrier" ::: "memory");
    const lds_cptr trb = (lds_cptr)shm + ((lane >> 4) & 1) * 32 + (lane & 3) * 8 + (4 * hi + ((lane & 15) >> 2)) * 64;
    bf16x8 vf[8];
#pragma unroll
    for (int ks = 0; ks < 8; ++ks) { const s16x4 lo = vtr(trb + VIMG + wid * 8192 + ks * 1024), hh = vtr(trb + VIMG + wid * 8192 + ks * 1024 + 512);
        vf[ks] = (bf16x8){lo[0], lo[1], lo[2], lo[3], hh[0], hh[1], hh[2], hh[3]}; }
    unsigned short* dst = KV + (size_t)item * 32768 + (size_t)wid * 64 * 16 + lane * 16;
#pragma unroll
    for (int kb = 0; kb < 4; ++kb) {
        f32x16 acc = {};
#pragma unroll
        for (int ks = 0; ks < 8; ++ks) { const s16x4 lo = vtr(trb + KIMG + kb * 8192 + ks * 1024), hh = vtr(trb + KIMG + kb * 8192 + ks * 1024 + 512);
            const bf16x8 kf = (bf16x8){lo[0], lo[1], lo[2], lo[3], hh[0], hh[1], hh[2], hh[3]};
            acc = RT_MFMA(kf, vf[ks], acc); }
        u32x4 w0, w1;
        w0.x = cvtpk(acc[0], acc[1]); w0.y = cvtpk(acc[2], acc[3]); w0.z = cvtpk(acc[4], acc[5]); w0.w = cvtpk(acc[6], acc[7]);
        w1.x = cvtpk(acc[8], acc[9]); w1.y = cvtpk(acc[10], acc[11]); w1.z = cvtpk(acc[12], acc[13]); w1.w = cvtpk(acc[14], acc[15]);
        *(GAS u32x4*)(dst + (size_t)kb * 8 * 64 * 16) = w0; *(GAS u32x4*)(dst + (size_t)kb * 8 * 64 * 16 + 8) = w1;
    }
    asm volatile("s_waitcnt lgkmcnt(0)\n\ts_barrier" ::: "memory");
}

__device__ __forceinline__ void stage_b(const unsigned short* KV, unsigned short* ST, float lg0, float lg1, float lg2_, float lg3, int G) {
    const int NT = G * NWAVES * 64;
    for (int gt = blockIdx.x * (NWAVES * 64) + threadIdx.x; gt < BATCH * 4 * 4096; gt += NT) {
        const int bh = gt >> 12, e = gt & 4095, h = bh & 3;
        const float lg2 = h == 0 ? lg0 : (h == 1 ? lg1 : (h == 2 ? lg2_ : lg3)), g1 = exp2f(lg2), g127 = exp2f(127.0f * lg2), g128 = exp2f(128.0f * lg2);
        const GAS u32x4* src = (const GAS u32x4*)(KV + (size_t)bh * 32 * 32768) + e; GAS u32x4* dst = (GAS u32x4*)(ST + (size_t)bh * 32 * 32768) + e;
        float a[8];
#pragma unroll
        for (int i = 0; i < 8; ++i) a[i] = 0.f;
#pragma unroll 8
        for (int j = 0; j < 32; ++j) {
            u32x4 o; o.x = cvtpk(a[0] * g1, a[1] * g1); o.y = cvtpk(a[2] * g1, a[3] * g1); o.z = cvtpk(a[4] * g1, a[5] * g1); o.w = cvtpk(a[6] * g1, a[7] * g1);
            dst[(size_t)j * 4096] = o;
            if (j < 31) { const u32x4 k = src[(size_t)j * 4096];
                a[0] = g128 * a[0] + g127 * bflo(k.x); a[1] = g128 * a[1] + g127 * bfhi(k.x); a[2] = g128 * a[2] + g127 * bflo(k.y); a[3] = g128 * a[3] + g127 * bfhi(k.y);
                a[4] = g128 * a[4] + g127 * bflo(k.z); a[5] = g128 * a[5] + g127 * bfhi(k.z); a[6] = g128 * a[6] + g127 * bflo(k.w); a[7] = g128 * a[7] + g127 * bfhi(k.w); }
        }
    }
}

__device__ __forceinline__ void stage_b_group(unsigned short* KV, int bh, int m, float lg2) {
    const float g1 = exp2f(lg2), g127 = exp2f(127.0f * lg2), g128 = exp2f(128.0f * lg2);
    GAS u32x4* p = (GAS u32x4*)(KV + (size_t)bh * 32 * 32768) + (m * 512 + (int)threadIdx.x);
    float a[8];
#pragma unroll
    for (int i = 0; i < 8; ++i) a[i] = 0.f;
    for (int j0 = 0; j0 < 32; j0 += 8) {
        u32x4 k[8];
#pragma unroll
        for (int jj = 0; jj < 8; ++jj) k[jj] = p[(size_t)(j0 + jj) * 4096];
#pragma unroll
        for (int jj = 0; jj < 8; ++jj) {
            u32x4 o; o.x = cvtpk(a[0] * g1, a[1] * g1); o.y = cvtpk(a[2] * g1, a[3] * g1); o.z = cvtpk(a[4] * g1, a[5] * g1); o.w = cvtpk(a[6] * g1, a[7] * g1);
            p[(size_t)(j0 + jj) * 4096] = o;
            a[0] = g128 * a[0] + g127 * bflo(k[jj].x); a[1] = g128 * a[1] + g127 * bfhi(k[jj].x); a[2] = g128 * a[2] + g127 * bflo(k[jj].y); a[3] = g128 * a[3] + g127 * bfhi(k[jj].y);
            a[4] = g128 * a[4] + g127 * bflo(k[jj].z); a[5] = g128 * a[5] + g127 * bfhi(k[jj].z); a[6] = g128 * a[6] + g127 * bflo(k[jj].w); a[7] = g128 * a[7] + g127 * bfhi(k[jj].w);
        }
    }
}

constexpr int STG = STATS + 2048;
__device__ __forceinline__ void dma_c(int item, const unsigned short* KR, const unsigned short* VR, int wid, int lane, unsigned lds0) {
    const int j = item & 31, bh = item >> 5, h = bh & 3, b = bh >> 2;
    const size_t tok0 = (size_t)b * SEQ + j * 128;
    const unsigned short* src = KR + (((tok0 >> 4) + 4 * (wid & 1) + (lane >> 4)) * 16 + h * 4) * 512 + ((lane & 15) * 4 + (wid >> 1)) * 8;
#pragma unroll
    for (int i = 0; i < 4; ++i) glds16(src + i * 512, (unsigned)__builtin_amdgcn_readfirstlane(lds0 + KIMG + (wid + 8 * i) * 1024));
    dma_v(VR, tok0, h, wid, lane, lds0);
}
__device__ __forceinline__ void stage_c_items(int item0, int NI, const unsigned short* QR, const unsigned short* KR, const unsigned short* VR, const unsigned short* ST, const unsigned short* GS, const float* gnw,
                                              unsigned short* ORR, __attribute__((address_space(3))) unsigned char* shm, unsigned long long& tacc) {
    const int wid = __builtin_amdgcn_readfirstlane(threadIdx.x >> 6), rb = wid >> 1, dh = wid & 1;
    unsigned long long tt_ = 0;
#define RC_T0(k) do { if (PROBE_TK == (k) && wid == PROBE_TW) { RT_SB(); tt_ = __builtin_amdgcn_s_memrealtime(); RT_SB(); } } while (0)
#define RC_T1(k) do { if (PROBE_TK == (k) && wid == PROBE_TW) { RT_SB(); tacc += __builtin_amdgcn_s_memrealtime() - tt_; RT_SB(); } } while (0)
    const unsigned lds0 = (unsigned)(uintptr_t)shm;
    asm volatile("s_waitcnt vmcnt(0) lgkmcnt(0)\n\ts_barrier" ::: "memory");
    dma_c(item0, KR, VR, wid, threadIdx.x & 63, lds0);
    for (int ii = 0; ii < NI; ++ii) {
        int tid = threadIdx.x; asm volatile("" : "+v"(tid));
        const int lane = tid & 63, r32 = lane & 31, hi = lane >> 5;
        const int item = item0 + ii, j = item & 31, bh = item >> 5, h = bh & 3, b = bh >> 2;
        const size_t tok0 = (size_t)b * SEQ + j * 128;
        RC_T0(21);
        bf16x8 qn[8];
        {
          const unsigned short* qp = QR + (((tok0 >> 4) + 2 * rb + (r32 >> 4)) * 16 + h * 4) * 512 + ((r32 & 15) * 4 + hi) * 8;
#pragma unroll
          for (int s = 0; s < 8; ++s) qn[s] = *(const GAS bf16x8*)(qp + (s >> 1) * 512 + (s & 1) * 16); }
        f32x16 O[4];
#pragma unroll
        for (int i = 0; i < 4; ++i) O[i] = f32x16{};
        if (j > 0) {
            const unsigned short* sp = ST + (size_t)item * 32768 + (size_t)(4 * dh) * 64 * 16 + lane * 16;
            bf16x8 fa[2][4], fb[2][4];
#define RC_LOAD(f, q) do { _Pragma("unroll") for (int s2 = 0; s2 < 2; ++s2) _Pragma("unroll") for (int db = 0; db < 4; ++db) f[s2][db] = *(const GAS bf16x8*)(sp + (size_t)((q) * 8 + db) * 64 * 16 + s2 * 8); } while (0)
#define RC_USE(f, q) do { _Pragma("unroll") for (int s2 = 0; s2 < 2; ++s2) { const u32x4 qv = __builtin_bit_cast(u32x4, qn[2 * (q) + s2]); \
                const auto r0 = __builtin_amdgcn_permlane32_swap(qv.x, qv.z, false, false), r1 = __builtin_amdgcn_permlane32_swap(qv.y, qv.w, false, false); \
                u32x4 pv; pv.x = r0[0]; pv.y = r1[0]; pv.z = r0[1]; pv.w = r1[1]; const bf16x8 qa = __builtin_bit_cast(bf16x8, pv); \
                _Pragma("unroll") for (int db = 0; db < 4; ++db) O[db] = RT_MFMA(qa, f[s2][db], O[db]); } } while (0)
            RC_LOAD(fa, 0); RC_LOAD(fb, 1); RT_SB();
            RC_USE(fa, 0); RT_SB(); RC_LOAD(fa, 2); RT_SB();
            RC_USE(fb, 1); RT_SB(); RC_LOAD(fb, 3); RT_SB();
            RC_USE(fa, 2); RT_SB(); RC_USE(fb, 3); RT_SB();
#undef RC_LOAD
#undef RC_USE
        }
        RC_T1(21); RC_T0(22);
        asm volatile("s_waitcnt vmcnt(0)\n\ts_barrier" ::: "memory");
        RC_T1(22); RC_T0(23);
        const size_t obase = (tok0 + 32 * rb) * 1024 + h * 256 + 128 * dh;
        u32x4 gpre[8];
#pragma unroll
        for (int i = 0; i < 8; ++i) { const int hf = i >> 2, row = ((i & 3) >> 1) * 16 + (lane >> 2), ch = (i & 1) * 4 + (lane & 3); gpre[i] = *(const GAS u32x4*)(GS + obase + (size_t)row * 1024 + hf * 64 + ch * 8); }
        const lds_cptr kp = (lds_cptr)shm + KIMG + hi * 2048 + r32 * 16;
        const lds_cptr vp = (lds_cptr)shm + VIMG + (4 * dh) * 8192 + ((lane >> 4) & 1) * 32 + (lane & 3) * 8 + (4 * hi + ((lane & 15) >> 2)) * 64;
        for (int kb = 0; kb <= rb; ++kb) {
            f32x16 s = {};
#pragma unroll
            for (int ks = 0; ks < 8; ++ks) { const bf16x8 kf = *(const __attribute__((address_space(3))) bf16x8*)(kp + ks * 4096 + kb * 512); s = RT_MFMA(kf, qn[ks], s); }
            if (kb == rb) {
#pragma unroll
                for (int r = 0; r < 16; ++r) { if (crow(r, hi) > r32) s[r] = 0.f; }
            }
            RT_SB();
            u32x4 w0, w1;
            w0.x = cvtpk(s[0], s[1]); w0.y = cvtpk(s[2], s[3]); w0.z = cvtpk(s[4], s[5]); w0.w = cvtpk(s[6], s[7]);
            w1.x = cvtpk(s[8], s[9]); w1.y = cvtpk(s[10], s[11]); w1.z = cvtpk(s[12], s[13]); w1.w = cvtpk(s[14], s[15]);
            const bf16x8 pa0 = __builtin_bit_cast(bf16x8, w0), pa1 = __builtin_bit_cast(bf16x8, w1);
#pragma unroll
            for (int i = 0; i < 8; ++i) { const int ks2 = i >> 2, db = i & 3;
                const s16x4 lo = vtr(vp + db * 8192 + (2 * kb + ks2) * 1024), hh = vtr(vp + db * 8192 + (2 * kb + ks2) * 1024 + 512);
                const bf16x8 vf = (bf16x8){lo[0], lo[1], lo[2], lo[3], hh[0], hh[1], hh[2], hh[3]};
                O[db] = RT_MFMA(ks2 == 0 ? pa0 : pa1, vf, O[db]); }
            RT_SB();
        }
        RC_T1(23); RC_T0(24);
        float s1[16], s2[16];
#pragma unroll
        for (int r = 0; r < 16; ++r) { float a = 0.f, q = 0.f;
#pragma unroll
            for (int db = 0; db < 4; ++db) { a += O[db][r]; q += O[db][r] * O[db][r]; }
            s1[r] = a; s2[r] = q; }
#pragma unroll
        for (int o = 1; o < 32; o <<= 1) {
#pragma unroll
            for (int r = 0; r < 16; ++r) { s1[r] += __shfl_xor(s1[r], o); s2[r] += __shfl_xor(s2[r], o); } }
        typedef float f32x2v __attribute__((ext_vector_type(2)));
        __attribute__((address_space(3))) f32x2v* stt = (__attribute__((address_space(3))) f32x2v*)(shm + STATS);
        if (r32 == 0) {
#pragma unroll
            for (int r = 0; r < 16; ++r) stt[wid * 32 + crow(r, hi)] = (f32x2v){s1[r], s2[r]};
        }
        RC_T1(24); RC_T0(25);
        asm volatile("s_waitcnt vmcnt(0) lgkmcnt(0)\n\ts_barrier" ::: "memory");
        RC_T1(25); RC_T0(26);
        float gw[2][2];
#pragma unroll
        for (int hf = 0; hf < 2; ++hf)
#pragma unroll
            for (int d2 = 0; d2 < 2; ++d2) gw[hf][d2] = ((const GAS float*)gnw)[h * 256 + 128 * dh + hf * 64 + d2 * 32 + r32];
        asm volatile("" :: "v"(gw[0][0]), "v"(gw[0][1]), "v"(gw[1][0]), "v"(gw[1][1]), "v"(gpre[0]), "v"(gpre[1]), "v"(gpre[2]), "v"(gpre[3]), "v"(gpre[4]), "v"(gpre[5]), "v"(gpre[6]), "v"(gpre[7]));
        if (ii + 1 < NI) dma_c(item + 1, KR, VR, wid, lane, lds0);
        __attribute__((address_space(3))) unsigned short* stg = (__attribute__((address_space(3))) unsigned short*)(shm + STG + wid * 4096);
        float mu_[16], rs_[16];
#pragma unroll
        for (int r = 0; r < 16; ++r) { const int row = crow(r, hi); const f32x2v pa = stt[wid * 32 + row], pb = stt[(wid ^ 1) * 32 + row];
            const float mu = (pa.x + pb.x) * (1.0f / 256.0f), var = (pa.y + pb.y) * (1.0f / 256.0f) - mu * mu; mu_[r] = mu; rs_[r] = __builtin_amdgcn_rsqf(var + 1e-5f); }
#pragma unroll
        for (int hf = 0; hf < 2; ++hf) {
#pragma unroll
            for (int r = 0; r < 16; ++r) { const int row = crow(r, hi);
#pragma unroll
                for (int d2 = 0; d2 < 2; ++d2) stg[row * 64 + (d2 ^ ((r >> 1) & 1)) * 32 + r32] = (unsigned short)cvtpk((O[2 * hf + d2][r] - mu_[r]) * rs_[r] * gw[hf][d2], 0.f); }
            asm volatile("s_waitcnt lgkmcnt(0)" ::: "memory");
#pragma unroll
            for (int i = 0; i < 4; ++i) { const int rbk = i >> 1, cb = i & 1, row = rbk * 16 + (lane >> 2);
                const u32x4 v = *(const __attribute__((address_space(3))) u32x4*)(stg + row * 64 + ((cb ^ ((lane >> 3) & 1)) * 32) + (lane & 3) * 8);
                const u32x4 g = gpre[hf * 4 + i];
                u32x4 o; o.x = cvtpk(bflo(v.x) * bflo(g.x), bfhi(v.x) * bfhi(g.x)); o.y = cvtpk(bflo(v.y) * bflo(g.y), bfhi(v.y) * bfhi(g.y));
                o.z = cvtpk(bflo(v.z) * bflo(g.z), bfhi(v.z) * bfhi(g.z)); o.w = cvtpk(bflo(v.w) * bflo(g.w), bfhi(v.w) * bfhi(g.w));
                *(GAS u32x4*)(ORR + ((size_t)((((tok0 + 32 * rb) >> 4) + rbk) * 48 + 16 + h * 8 + dh * 4 + hf * 2 + cb)) * 512 + lane * 8) = o; }
            asm volatile("s_waitcnt lgkmcnt(0)" ::: "memory");
        }
        RC_T1(26);
    }
    asm volatile("s_waitcnt vmcnt(0) lgkmcnt(0)\n\ts_barrier" ::: "memory");
#undef RC_T0
#undef RC_T1
}
#undef RT_MFMA
#undef RT_SB
}

__device__ __forceinline__ int vcu_of(int bx, int G) { return (G % 8 == 0) ? (bx % 8) * (G / 8) + bx / 8 : bx; }
__device__ __forceinline__ void ret_a_phase(Frame& F) {
    for (int it = 4 * vcu_of(blockIdx.x, F.G); it < BATCH * 4 * 32; it += 4 * F.G)
        for (int k = 0; k < 4; ++k) rtn::stage_a_item(it + k, (const unsigned short*)(F.ws + WS_KR), (const unsigned short*)(F.ws + WS_VR), (unsigned short*)(F.ws + WS_KV), F.lds);
}
__device__ __forceinline__ void ret_c_phase(Frame& F, const Args& A, size_t st_off = WS_ST) {
    for (int it = 4 * vcu_of(blockIdx.x, F.G); it < BATCH * 4 * 32; it += 4 * F.G)
        rtn::stage_c_items(it, 4, (const unsigned short*)(F.ws + WS_QR), (const unsigned short*)(F.ws + WS_KR), (const unsigned short*)(F.ws + WS_VR), (const unsigned short*)(F.ws + st_off),
                           (const unsigned short*)(F.ws + WS_GS), (const float*)A.in[12], (unsigned short*)(F.ws + WS_OA), F.lds, F.tacc);
}


__device__ __forceinline__ void group_sync(Frame& F, unsigned* ctr) {
    asm volatile("s_waitcnt vmcnt(0)" ::: "memory");
    __syncthreads();
    if (F.tid == 0) {
        __builtin_amdgcn_fence(__ATOMIC_RELEASE, "agent");
        asm volatile("s_waitcnt vmcnt(0)" ::: "memory");
        (void)__hip_atomic_fetch_add(ctr, 1u, __ATOMIC_RELAXED, __HIP_MEMORY_SCOPE_AGENT);
        unsigned sp = 0;
        while (__hip_atomic_load(ctr, __ATOMIC_RELAXED, __HIP_MEMORY_SCOPE_AGENT) < 8u) { __builtin_amdgcn_s_sleep(4); if (++sp > (1u << 20)) break; }
        __builtin_amdgcn_fence(__ATOMIC_ACQUIRE, "agent");
        asm volatile("s_waitcnt vmcnt(0)" ::: "memory");
    }
    __syncthreads();
}
__device__ __forceinline__ void p2_fused(Frame& F, const Args& A) {
    const int vcu = vcu_of(blockIdx.x, F.G), g = vcu >> 3, m = vcu & 7;
    unsigned* c0 = (unsigned*)(F.ctl + 8192 + 2048 + 64 * g);
    for (int step = 0; step < 2; ++step) {
        if (((g & 1) ^ step) == 0) { attn_phase(F, A); }
        else {
            ret_a_phase(F);
            group_sync(F, c0);
            rtn::stage_b_group((unsigned short*)(F.ws + WS_KV), g, m, A.lg2[g & 3]);
            group_sync(F, c0 + 32);
            ret_c_phase(F, A, WS_KV);
        }
    }
}
__global__ void __launch_bounds__(NWAVES * 64, 2) hybrid_fwd(Args args) {
    extern __shared__ __attribute__((aligned(16))) unsigned char lds[];
    Frame F;
    F.lds = (LAS unsigned char*)lds; F.MISC = (volatile LAS unsigned*)(F.lds + MISC_OFF);
    F.tid = threadIdx.x; F.lane = F.tid & 63; F.wave = __builtin_amdgcn_readfirstlane(F.tid >> 6); F.G = gridDim.x;
    F.ws = args.ws; F.ctl = (gu32*)(args.ws + WS_CTL); F.tacc = 0;
    for (int u = F.tid; u < (LDS_BYTES - MISC_OFF) / 4; u += NWAVES * 64) ((LAS unsigned*)(F.lds + MISC_OFF))[u] = 0u;
    __syncthreads();
    XcdBarrier bar; bar.bar = (unsigned*)(F.ctl + CW_BAR) + args.li * XCD_BAR_WORDS; bar.x = 0; bar.st = nullptr;
    if (MK_N_LAUNCHES != N_PHASES) bar = xcd_barrier_post((unsigned*)(F.ctl + CW_BAR) + args.li * XCD_BAR_WORDS, F.MISC + 8);
    const int lo = args.ph_lo, hi = args.ph_hi;
#define IN(k) (lo <= (k) && (k) < hi)
#ifndef PROBE_CLK
#define PROBE_CLK -1
#define PROBE_CLK_E -1
#define PROBE_CLK_DUR 0
#endif
    unsigned long long clk_m0 = 0, clk_r0 = 0, clk_ticks = 0;
#define CLK_BEG(k) do { if (PROBE_CLK == (k) && blockIdx.x == 0) { clk_m0 = __builtin_amdgcn_s_memtime(); clk_r0 = __builtin_amdgcn_s_memrealtime(); } } while (0)
#define CLK_END(k) do { if (PROBE_CLK_E == (k) && blockIdx.x == 0) { const unsigned long long dm = __builtin_amdgcn_s_memtime() - clk_m0, dr = __builtin_amdgcn_s_memrealtime() - clk_r0; clk_ticks = PROBE_CLK_DUR ? dr : (unsigned long long)((double)dm * 1000.0 / (double)dr); } } while (0)
#ifndef PROBE_BAR2
#define PROBE_BAR2 0
#endif
#define SEAM(k) do { if (IN(k) && IN((k) + 1)) { xcd_barrier(bar); if (PROBE_BAR2) xcd_barrier(bar); } } while (0)
#ifndef PROBE_DUP
#define PROBE_DUP 0
#endif
#define REP(k) for (int rep_ = 0; rep_ < 1 + ((PROBE_DUP >> (k)) & 1); ++rep_)
#define PHASE_WS() unsigned char* ws = args.ws; asm volatile("" : "+s"(ws)); F.ws = ws
    if (IN(0)) { PHASE_WS(); CLK_BEG(0); REP(0) p0_prologue(F, args); CLK_END(0); SEAM(0); }
    if (IN(1)) { PHASE_WS(); CLK_BEG(1); REP(1) {
        pg8::Gemm g{(const bf16_t*)(ws + WS_XN), (const bf16_t*)(ws + WS_WIN), M, INW, DM}; P1Order S; S.init(M, INW, F.G, (int)blockIdx.x);
        EpiProj E{(bf16_t*)(ws + WS_QD), (bf16_t*)(ws + WS_KD), (bf16_t*)(ws + WS_QR), (bf16_t*)(ws + WS_KR), (bf16_t*)args.out, ws,
                  (const int*)args.in[1], (const float*)args.in[4], (const float*)args.in[5], args.lg2[0], args.lg2[1], args.lg2[2], args.lg2[3]};
        pg8::gemm_phase<EpiProj, P1Order, true, true>(F.lds, g, S, E); }
        CLK_END(1); SEAM(1);
    }
    if (IN(2)) { PHASE_WS();
        if (F.G == 256) { p2_fused(F, args);
            const int vcu = vcu_of(blockIdx.x, F.G), g = vcu >> 3, m = vcu & 7; if (!(g & 1)) p2_weights(F, args, (((g >> 1) * 8 + m) * NWAVES) + F.wave, 128 * NWAVES); }
        else { if ((blockIdx.x >> 3) & 1) { ret_a_phase(F); attn_phase(F, args); } else { attn_phase(F, args); ret_a_phase(F); } p2_weights(F, args); }
        SEAM(2); }
    if (IN(3) && F.G != 256) { PHASE_WS(); rtn::stage_b((const unsigned short*)(ws + WS_KV), (unsigned short*)(ws + WS_ST), args.lg2[0], args.lg2[1], args.lg2[2], args.lg2[3], F.G); xcd_barrier(bar); }
    if (IN(4) && F.G != 256) { PHASE_WS(); ret_c_phase(F, args); xcd_barrier(bar); }
    if (IN(5)) { PHASE_WS(); CLK_BEG(5); REP(5) {
        pg8::Gemm g{(const bf16_t*)(ws + WS_OA), (const bf16_t*)(ws + WS_WA), M, DM, 1536}; pg8::StaticOrder S; S.init(M, DM, F.G, (int)blockIdx.x);
        EpiMerge2 E{(const bf16_t*)args.out, (bf16_t*)(ws + WS_MRG)};
        pg8::gemm_phase<EpiMerge2, pg8::StaticOrder, true, true>(F.lds, g, S, E); }
        CLK_END(5); SEAM(5);
    }
    if (IN(6)) { PHASE_WS(); CLK_BEG(6); REP(6) {
        pg8::Gemm g{(const bf16_t*)(ws + WS_MRG), (const bf16_t*)(ws + WS_WO), M, DM, DM}; pg8::StaticOrder S; S.init(M, DM, F.G, (int)blockIdx.x);
        EpiX1 E{(const float*)args.in[0], args.out, (bf16_t*)(ws + WS_XN), (float*)(ws + WS_RSS)};
        pg8::gemm_phase<EpiX1, pg8::StaticOrder, true, true>(F.lds, g, S, E); }
        CLK_END(6); SEAM(6);
    }
    if (IN(7)) { PHASE_WS(); CLK_BEG(7);
#if PROBE_XCC
        { const unsigned xcc = xb_xcc_id(); if (xcc != (blockIdx.x & 7u)) { if (F.tid == 0) { ((GAS float*)(ws + WS_RSS))[0] = __builtin_nanf(""); } } }
#endif
        for (int hf_ = 0; hf_ < 2; ++hf_) {
            int hf = hf_; asm volatile("" : "+s"(hf));
            const size_t r0 = (size_t)hf * (M / 2);
            { pg8::Gemm g{(const bf16_t*)(ws + WS_XN) + r0 * DM, (const bf16_t*)(ws + WS_W1), M / 2, FF, DM}; pg8::StaticOrder S; S.init(M / 2, FF, F.G, (int)blockIdx.x);
              EpiHid E{(const float*)(ws + WS_RSS) + r0 * 16, (bf16_t*)(ws + WS_HID) + r0 * FF};
              pg8::gemm_phase<EpiHid, pg8::StaticOrder, true, true>(F.lds, g, S, E); }
            xcd_barrier(bar);
            { pg8::Gemm g{(const bf16_t*)(ws + WS_HID) + r0 * FF, (const bf16_t*)(ws + WS_W2), M / 2, DM, FF}; RevOrder S; S.init(M / 2, DM, F.G, (int)blockIdx.x);
              EpiOut E{args.out + r0 * DM, (const bf16_t*)(ws + WS_XN) + r0 * DM};
              pg8::gemm_phase<EpiOut, RevOrder, true, true>(F.lds, g, S, E); }
        }
        CLK_END(7);
    }
    if (PROBE_TK > 0 && blockIdx.x == 0 && F.wave == PROBE_TW) { const unsigned long long t0 = __builtin_amdgcn_s_memrealtime(), tk = (PROBE_TK >= 5 && PROBE_TK < 20 ? (unsigned long long)*(LAS unsigned*)(F.lds + LDS_BYTES - 128) : F.tacc) * PROBE_TS; while (__builtin_amdgcn_s_memrealtime() - t0 < tk) __builtin_amdgcn_s_sleep(20); }
    if (PROBE_CLK >= 0 && blockIdx.x == 0 && F.wave == 0) { const unsigned long long t0 = __builtin_amdgcn_s_memrealtime(); while (__builtin_amdgcn_s_memrealtime() - t0 < clk_ticks) __builtin_amdgcn_s_sleep(20); }
#undef IN
#undef SEAM
}

extern "C" void kernel_launch(void* const* d_in, const int* in_sizes, int n_in, void* d_out, int out_size, void* d_ws, size_t ws_size, hipStream_t stream) {
    static int grid = 0;
    if (grid == 0) {
        if (n_in != 18 || in_sizes[0] != M * DM || out_size != M * DM || ws_size < WS_END) { fprintf(stderr, "kernel_launch: unexpected shapes (n_in %d, in0 %d, out %d, ws %zu)\n", n_in, n_in > 0 ? in_sizes[0] : -1, out_size, ws_size); grid = -1; return; }
        int dev = 0, cus = 0;
        if (hipGetDevice(&dev) != hipSuccess || hipDeviceGetAttribute(&cus, hipDeviceAttributeMultiprocessorCount, dev) != hipSuccess) { grid = -1; return; }
        if (hipFuncSetAttribute((const void*)hybrid_fwd, hipFuncAttributeMaxDynamicSharedMemorySize, LDS_BYTES) != hipSuccess) { fprintf(stderr, "kernel_launch: hipFuncSetAttribute failed\n"); grid = -1; return; }
        int per_cu = 0;
        if (hipOccupancyMaxActiveBlocksPerMultiprocessor(&per_cu, (const void*)hybrid_fwd, NWAVES * 64, LDS_BYTES) != hipSuccess || per_cu < 1) fprintf(stderr, "kernel_launch: occupancy query says %d\n", per_cu);
        (void)hipGetLastError();
        grid = cus >= 256 ? 256 : cus;
    }
    if (grid < 0) return;
    hipMemsetAsync((char*)d_ws + WS_CTL, 0, CTL_ZERO_BYTES, stream);
    Args a{};
    for (int i = 0; i < 18; ++i) a.in[i] = d_in[i];
    a.out = (float*)d_out; a.ws = (unsigned char*)d_ws;
    for (int j = 0; j < 8; ++j) a.invf[j] = std::pow(500000.0, -(double)(2 * j) / 16.0);
    for (int j = 0; j < 64; ++j) a.invf[8 + j] = 1.0 / std::pow(10000.0, (double)j / 63.0);
    for (int hh = 0; hh < 4; ++hh) a.lg2[hh] = (float)std::log2(1.0 - std::exp2(-5.0 - (double)hh));
    const int nl = MK_N_LAUNCHES;
    for (int li = 0; li < nl; ++li) {
        if (nl == N_PHASES) { a.ph_lo = li; a.ph_hi = li + 1; a.li = 0; }
        else { a.ph_lo = li * N_PHASES / nl; a.ph_hi = (li + 1) * N_PHASES / nl; a.li = li; }
        hipLaunchKernelGGL(hybrid_fwd, dim3(grid), dim3(NWAVES * 64), LDS_BYTES, stream, a);
    }
}
```
